# Optimizing an MI355X kernel written in HIP

```python
import jax, jax.numpy as jnp
from jax import lax
import numpy as np

D_MODEL = 1024
BATCH = 8
SEQ = 8192
DEPTH = 1
DEC_BATCH = 2
DEC_SEQ = 16384
PAST_LEN = 128

GRID_W = 64
NA_HEADS = 8
NA_HEAD_DIM = 64
NA_WIN_H = 8
NA_WIN_W = 16
MLA_HEADS = 8
MLA_NOPE = 64
MLA_ROPE = 32
MLA_V = 64
Q_LORA = 384
KV_LORA = 256
ROPE_THETA = 10000.0
Q_BLOCK = 128
D_FF = -(-8 * D_MODEL // (3 * 256)) * 256
PLE_DIM = 256
EPS = 1e-6
NA_WIDTH = NA_HEADS * NA_HEAD_DIM
MLA_WIDTH = MLA_HEADS * MLA_V
IN_SPLITS = (NA_WIDTH, NA_WIDTH, NA_WIDTH, Q_LORA, KV_LORA, MLA_ROPE, 2 * D_MODEL)
IN_COLS = sum(IN_SPLITS)

kernel_name = 'hybrid_natten_mla_encoder'


def _rmsnorm(x, g):
    xf = x.astype(jnp.float32)
    y = xf * lax.rsqrt(jnp.mean(xf * xf, axis=-1, keepdims=True) + EPS)
    return (y * g.astype(jnp.float32)).astype(x.dtype)


def _rope(x, pos):
    half = x.shape[-1] // 2
    freqs = ROPE_THETA ** (-jnp.arange(half, dtype=jnp.float32) / half)
    ang = pos[:, None] * freqs[None, :]
    cos = jnp.cos(ang)[:, None, :]
    sin = jnp.sin(ang)[:, None, :]
    xf = x.astype(jnp.float32)
    x1, x2 = xf[..., :half], xf[..., half:]
    out = jnp.concatenate([x1 * cos - x2 * sin, x2 * cos + x1 * sin], axis=-1)
    return out.astype(x.dtype)


def _neighbourhood_attention(q, k, v, rpb):
    B, S, H, d = q.shape
    rows = S // GRID_W
    kh = min(NA_WIN_H, rows)
    kw = NA_WIN_W
    qg = (q * (d ** -0.5)).reshape(B, rows, GRID_W, H, d).transpose(1, 0, 2, 3, 4)
    kg = k.reshape(B, rows, GRID_W, H, d)
    vg = v.reshape(B, rows, GRID_W, H, d)
    cols = np.arange(GRID_W)
    cs = np.clip(cols - kw // 2, 0, GRID_W - kw)
    col_idx = cs[:, None] + np.arange(kw)[None, :]
    cb_idx = col_idx - cols[:, None] + (kw - 1)
    rpb_c = rpb[:, :, cb_idx]

    def row_fn(args):
        r, q_row = args
        rs = jnp.clip(r - kh // 2, 0, rows - kh)
        k_rows = lax.dynamic_slice_in_dim(kg, rs, kh, axis=1)
        v_rows = lax.dynamic_slice_in_dim(vg, rs, kh, axis=1)
        k_win = k_rows[:, :, col_idx]
        v_win = v_rows[:, :, col_idx]
        rb_idx = rs + jnp.arange(kh) - r + (NA_WIN_H - 1)
        bias = rpb_c[:, rb_idx].transpose(0, 2, 1, 3)
        s = jnp.einsum('bchd,bicjhd->bhcij', q_row, k_win).astype(jnp.float32)
        s = s + bias.astype(jnp.float32)[None]
        p = jax.nn.softmax(s.reshape(B, H, GRID_W, kh * kw), axis=-1).reshape(B, H, GRID_W, kh, kw)
        return jnp.einsum('bhcij,bicjhd->bchd', p.astype(v.dtype), v_win)

    out = lax.map(row_fn, (jnp.arange(rows), qg))
    return out.transpose(1, 0, 2, 3, 4).reshape(B, S, H * d)


def _latent_attention(zq, zkv, zr, g_q_lat, w_uq, g_kv_lat, w_ukv):
    B, S, _ = zq.shape
    pos = jnp.arange(S, dtype=jnp.float32)
    q = (_rmsnorm(zq, g_q_lat) @ w_uq).reshape(B, S, MLA_HEADS, MLA_NOPE + MLA_ROPE)
    kv = (_rmsnorm(zkv, g_kv_lat) @ w_ukv).reshape(B, S, MLA_HEADS, MLA_NOPE + MLA_V)
    k_nope, v = kv[..., :MLA_NOPE], kv[..., MLA_NOPE:]
    k_rope = _rope(zr[:, :, None, :], pos)
    scale = (MLA_NOPE + MLA_ROPE) ** -0.5
    q = jnp.concatenate([q[..., :MLA_NOPE], _rope(q[..., MLA_NOPE:], pos)], axis=-1) * scale
    k = jnp.concatenate([k_nope, jnp.broadcast_to(k_rope, (B, S, MLA_HEADS, MLA_ROPE))], axis=-1)
    nblk = S // Q_BLOCK
    qb = q.reshape(B, nblk, Q_BLOCK, MLA_HEADS, MLA_NOPE + MLA_ROPE).transpose(1, 0, 2, 3, 4)

    def blk(q_blk):
        s = jnp.einsum('bqhd,bkhd->bhqk', q_blk, k).astype(jnp.float32)
        p = jax.nn.softmax(s, axis=-1)
        return jnp.einsum('bhqk,bkhd->bqhd', p.astype(v.dtype), v)

    out = lax.map(blk, qb)
    return out.transpose(1, 0, 2, 3, 4).reshape(B, S, MLA_WIDTH)


def _layer(x, p_i, g_mix, w_in, rpb, g_q_lat, w_uq, g_kv_lat, w_ukv, w_na_o, w_mla_o, w_out,
           g_ffn, w_gate_up, w_down, g_ple, w_ple_gate, w_ple):
    B, S, _ = x.shape
    h = _rmsnorm(x, g_mix)
    z = h @ w_in
    zq_na, zk_na, zv_na, zq_lat, zkv_lat, zr, zg = jnp.split(z, list(np.cumsum(IN_SPLITS)[:-1]), axis=-1)
    hs = (B, S, NA_HEADS, NA_HEAD_DIM)
    na = _neighbourhood_attention(zq_na.reshape(hs), zk_na.reshape(hs), zv_na.reshape(hs), rpb)
    mla = _latent_attention(zq_lat, zkv_lat, zr, g_q_lat, w_uq, g_kv_lat, w_ukv)
    gates = jax.nn.sigmoid(zg.astype(jnp.float32)).astype(x.dtype)
    g_a, g_b = gates[..., :D_MODEL], gates[..., D_MODEL:]
    x = x + (g_a * (na @ w_na_o) + g_b * (mla @ w_mla_o)) @ w_out
    gu = _rmsnorm(x, g_ffn) @ w_gate_up
    x = x + (jax.nn.silu(gu[..., :D_FF]) * gu[..., D_FF:]) @ w_down
    ple_gate = jax.nn.sigmoid((_rmsnorm(x, g_ple) @ w_ple_gate).astype(jnp.float32)).astype(x.dtype)
    return x + ple_gate * (p_i @ w_ple)


def _trunk(x, p, g_mix, w_in, rpb, g_q_lat, w_uq, g_kv_lat, w_ukv, w_na_o, w_mla_o, w_out,
           g_ffn, w_gate_up, w_down, g_ple, w_ple_gate, w_ple, g_final):
    for i in range(DEPTH):
        x = _layer(x, p[i], g_mix[i], w_in[i], rpb[i], g_q_lat[i], w_uq[i], g_kv_lat[i], w_ukv[i],
                   w_na_o[i], w_mla_o[i], w_out[i], g_ffn[i], w_gate_up[i], w_down[i],
                   g_ple[i], w_ple_gate[i], w_ple[i])
    return _rmsnorm(x, g_final)


def setup_inputs(seed: int = 0) -> dict:
    key = jax.random.key(seed)
    ks = jax.random.split(key, 24)
    f32 = jnp.float32

    def w(k, shape, fan_in):
        return jax.random.normal(k, shape, f32) * (fan_in ** -0.5)

    def gain(k, shape):
        return 1.0 + 0.05 * jax.random.normal(k, shape, f32)

    L = DEPTH
    return {
        'x_prompt': jax.random.normal(ks[0], (BATCH, SEQ, D_MODEL), f32),
        'x_sample': jax.random.normal(ks[1], (DEC_BATCH, DEC_SEQ, D_MODEL), f32),
        'p_prompt': jax.random.normal(ks[2], (DEPTH, BATCH, SEQ, PLE_DIM), f32),
        'p_sample': jax.random.normal(ks[3], (DEPTH, DEC_BATCH, DEC_SEQ, PLE_DIM), f32),
        'g_mix': gain(ks[4], (L, D_MODEL)),
        'w_in': w(ks[5], (L, D_MODEL, IN_COLS), D_MODEL),
        'rpb': 0.1 * jax.random.normal(ks[6], (L, NA_HEADS, 2 * NA_WIN_H - 1, 2 * NA_WIN_W - 1), f32),
        'g_q_lat': gain(ks[7], (L, Q_LORA)),
        'w_uq': w(ks[8], (L, Q_LORA, MLA_HEADS * (MLA_NOPE + MLA_ROPE)), Q_LORA),
        'g_kv_lat': gain(ks[9], (L, KV_LORA)),
        'w_ukv': w(ks[10], (L, KV_LORA, MLA_HEADS * (MLA_NOPE + MLA_V)), KV_LORA),
        'w_na_o': w(ks[11], (L, NA_WIDTH, D_MODEL), NA_WIDTH),
        'w_mla_o': w(ks[12], (L, MLA_WIDTH, D_MODEL), MLA_WIDTH),
        'w_out': w(ks[13], (L, D_MODEL, D_MODEL), D_MODEL),
        'g_ffn': gain(ks[14], (L, D_MODEL)),
        'w_gate_up': w(ks[15], (L, D_MODEL, 2 * D_FF), D_MODEL),
        'w_down': w(ks[16], (L, D_FF, D_MODEL), D_FF),
        'g_ple': gain(ks[17], (L, D_MODEL)),
        'w_ple_gate': w(ks[18], (L, D_MODEL, D_MODEL), D_MODEL),
        'w_ple': w(ks[19], (L, PLE_DIM, D_MODEL), PLE_DIM),
        'g_final': gain(ks[20], (D_MODEL,)),
    }


def reference(x_prompt, x_sample, p_prompt, p_sample, g_mix, w_in, rpb, g_q_lat, w_uq, g_kv_lat,
              w_ukv, w_na_o, w_mla_o, w_out, g_ffn, w_gate_up, w_down, g_ple, w_ple_gate, w_ple, g_final):
    y_prompt = _trunk(x_prompt, p_prompt, g_mix, w_in, rpb, g_q_lat, w_uq, g_kv_lat, w_ukv, w_na_o,
                      w_mla_o, w_out, g_ffn, w_gate_up, w_down, g_ple, w_ple_gate, w_ple, g_final)
    y_sample = _trunk(x_sample, p_sample, g_mix, w_in, rpb, g_q_lat, w_uq, g_kv_lat, w_ukv, w_na_o,
                      w_mla_o, w_out, g_ffn, w_gate_up, w_down, g_ple, w_ple_gate, w_ple, g_final)
    return (y_prompt, y_sample)
```

```cpp
#include <hip/hip_runtime.h>
#include <hip/hip_cooperative_groups.h>
#include <cstdio>
#include <cstdint>
namespace cg = cooperative_groups;
namespace pg8 {
#define PG8_LAS __attribute__((address_space(3)))
typedef unsigned short bf16_t;
typedef short bf16x8 __attribute__((ext_vector_type(8)));
typedef float f32x4 __attribute__((ext_vector_type(4)));
typedef unsigned u32x4 __attribute__((ext_vector_type(4)));
constexpr int BM = 256, BK = 64, HALF = 128, HTB = HALF * BK * 2  , STAGE_BYTES = 8 * HTB, NXCD = 8, WGM = 8;

__host__ __device__ __forceinline__ int lds_byte(int r, int c) { const int st = (r >> 4) * 2 + (c >> 5), rr = r & 15, cc = c & 31, ob = rr * 64 + cc * 2; return st * 1024 + (ob ^ (((ob >> 9) & 1) << 5)); }
__host__ __device__ __forceinline__ void stage_rc(int b, int& R, int& C) { const int st = b / 1024, sb = b % 1024, swz = sb ^ (((sb >> 9) & 1) << 5); R = (st >> 1) * 16 + swz / 64; C = (st & 1) * 32 + (swz % 64) / 2; }
__host__ __device__ __forceinline__ int perm32(int rho) { const int n = rho >> 4, i = rho & 15; return 8 * (i >> 2) + 4 * n + (i & 3); }

struct Unit { int pm, pn; int sel; };
struct Gemm { const bf16_t* A; const bf16_t* Bt; int M, N, K; int lda = 0, ldb = 0; const bf16_t* A2 = nullptr; const bf16_t* Bt2 = nullptr; };

struct StaticOrder {
    int nM, nN, nwg, G, c;
    __host__ __device__ void init(int M, int N, int G_, int c_) { nM = M / BM; nN = N / BM; nwg = nM * nN; G = G_; c = c_; }
    __host__ __device__ bool next(int i, Unit& u) const {
        const long L = (long)i * G + c; if (L >= nwg) return false;
        int wgid = (int)L; { const int q = nwg / NXCD, r = nwg % NXCD, xcd = wgid % NXCD, off = wgid / NXCD; wgid = (xcd < r ? xcd * (q + 1) : r * (q + 1) + (xcd - r) * q) + off; }
        const int nig = WGM * nN, gid = wgid / nig, fm = gid * WGM, gsz = (nM - fm) < WGM ? (nM - fm) : WGM;
        u.pm = fm + ((wgid % nig) % gsz); u.pn = (wgid % nig) / gsz; u.sel = 0; return true;
    }
    __device__ __forceinline__ void a_ready(const Unit&) const {}
    __device__ __forceinline__ void done(const Unit&) const {}
};

struct DualOrder {
    StaticOrder b;
    __host__ __device__ bool next(int i, Unit& u) const { const bool ok = b.next(i >> 1, u); u.sel = i & 1; return ok; }
    __device__ __forceinline__ void a_ready(const Unit&) const {}
    __device__ __forceinline__ void done(const Unit&) const {}
};
__device__ __forceinline__ unsigned cvt_pk_bf16(float lo, float hi) { unsigned r; asm volatile("v_cvt_pk_bf16_f32 %0, %1, %2" : "=v"(r) : "v"(lo), "v"(hi)); return r; }
typedef float f32x2 __attribute__((ext_vector_type(2)));
template <class Epi, class Sched, bool ALIGN_EPI = false, bool SP2 = false>
__device__ __forceinline__ void gemm_phase(PG8_LAS unsigned char* lds, const Gemm g, const Sched& S, const Epi& E, int tid_in) {
    int tid_ = tid_in; asm volatile("" : "+v"(tid_));
    const int tid = tid_, wid = __builtin_amdgcn_readfirstlane(tid >> 6), lane = tid & 63, wr = wid >> 2, wc = wid & 3, fr = lane & 15, fq = lane >> 4;
    const int K = g.K, nt = K / BK, lda = g.lda ? g.lda : K, ldb = g.ldb ? g.ldb : K;
    unsigned voffA[2], voffB[2];
#pragma unroll
    for (int i = 0; i < 2; ++i) { int R, C; stage_rc(tid * 16 + i * 8192, R, C); const int Rb = Epi::PERM ? ((R & ~31) + perm32(R & 31)) : R;
        voffA[i] = (unsigned)(R * lda + C) * 2u; voffB[i] = (unsigned)(Rb * ldb + C) * 2u; }
    const size_t kstep = (size_t)(BK * 2);
    const size_t hstepA = (size_t)HALF * lda * 2, hstepB = (size_t)HALF * ldb * 2;
    const size_t tstepA = 2 * hstepA, tstepB = 2 * hstepB;
    const unsigned ldsw = (unsigned)wid * 1024u;
    const int aoff = lds_byte(wr * 64 + fr, fq * 8), boff = lds_byte(wc * 32 + fr, fq * 8);
#define PG8_SA(b, h) (((b) * 2 + (h)) * HTB)
#define PG8_SB(b, h) ((4 + (b) * 2 + (h)) * HTB)
#define PG8_STAGE(bufoff, gbase, voff) do { _Pragma("unroll") for (int _i = 0; _i < 2; ++_i) \
        __builtin_amdgcn_global_load_lds((const unsigned*)((const char*)(gbase) + (voff)[_i]), (PG8_LAS unsigned*)(lds + (bufoff) + ldsw + _i * 8192), 16, 0, 0); } while (0)
#define PG8_LDA(dst, b, h) do { _Pragma("unroll") for (int m = 0; m < 4; ++m) _Pragma("unroll") for (int k = 0; k < 2; ++k) dst[m][k] = *(const PG8_LAS bf16x8*)(lds + PG8_SA(b, h) + aoff + m * 2048 + k * 1024); } while (0)
#define PG8_LDB(dst, b, h) do { _Pragma("unroll") for (int n = 0; n < 2; ++n) _Pragma("unroll") for (int k = 0; k < 2; ++k) dst[n][k] = *(const PG8_LAS bf16x8*)(lds + PG8_SB(b, h) + boff + n * 2048 + k * 1024); } while (0)
#define PG8_MMA(ai, bj, At, Bt) do { __builtin_amdgcn_s_setprio(1); _Pragma("unroll") for (int m = 0; m < 4; ++m) _Pragma("unroll") for (int n = 0; n < 2; ++n) _Pragma("unroll") for (int k = 0; k < 2; ++k) \
        acc[ai][bj][m][n] = __builtin_amdgcn_mfma_f32_16x16x32_bf16(Bt[n][k], At[m][k], acc[ai][bj][m][n], 0, 0, 0); __builtin_amdgcn_s_setprio(0); } while (0)
#define PG8_WAIT_V(n) asm volatile("s_waitcnt vmcnt(" #n ")" ::: "memory")
#define PG8_WAIT_L(n) asm volatile("s_waitcnt lgkmcnt(" #n ")" ::: "memory")
#define PG8_BAR __builtin_amdgcn_s_barrier()
#define PG8_SCHED __builtin_amdgcn_sched_barrier(0)
    Unit cur, nxt; int ui = 0;
    if (!S.next(0, cur)) return;
    f32x4 acc[2][2][4][2];
#pragma unroll
    for (int a = 0; a < 2; ++a)
#pragma unroll
        for (int b = 0; b < 2; ++b)
#pragma unroll
            for (int m = 0; m < 4; ++m)
#pragma unroll
                for (int n = 0; n < 2; ++n) acc[a][b][m][n] = (f32x4){0.f, 0.f, 0.f, 0.f};
    bf16x8 At[4][2], B0[2][2], B1[2][2];
    const char* cA = (const char*)(cur.sel ? g.A2 : g.A) + (size_t)cur.pm * tstepA; const char* cB = (const char*)(cur.sel ? g.Bt2 : g.Bt) + (size_t)cur.pn * tstepB;
    S.a_ready(cur);
    if constexpr (SP2) {
        PG8_STAGE(PG8_SB(0, 0), cB, voffB); PG8_STAGE(PG8_SB(0, 1), cB + hstepB, voffB); PG8_STAGE(PG8_SA(0, 0), cA, voffA); PG8_STAGE(PG8_SA(0, 1), cA + hstepA, voffA);
        if (wr == 1) PG8_BAR;
        PG8_WAIT_V(2); PG8_BAR;
        PG8_STAGE(PG8_SB(1, 0), cB + kstep, voffB); PG8_STAGE(PG8_SA(1, 0), cA + kstep, voffA); PG8_STAGE(PG8_SB(1, 1), cB + hstepB + kstep, voffB);
        PG8_WAIT_V(6); PG8_BAR;
    } else {
        PG8_STAGE(PG8_SB(0, 0), cB, voffB); PG8_STAGE(PG8_SA(0, 0), cA, voffA); PG8_STAGE(PG8_SB(0, 1), cB + hstepB, voffB); PG8_STAGE(PG8_SA(0, 1), cA + hstepA, voffA);
        if (wr == 1) PG8_BAR;
        PG8_WAIT_V(4); PG8_BAR;
        PG8_STAGE(PG8_SB(1, 0), cB + kstep, voffB); PG8_STAGE(PG8_SA(1, 0), cA + kstep, voffA); PG8_STAGE(PG8_SB(1, 1), cB + hstepB + kstep, voffB);
        PG8_WAIT_V(6); PG8_BAR;
    }
    for (;;) {
        const bool has_next = S.next(ui + 1, nxt);
        const char* nA = has_next ? (const char*)(nxt.sel ? g.A2 : g.A) + (size_t)nxt.pm * tstepA : cA; const char* nB = has_next ? (const char*)(nxt.sel ? g.Bt2 : g.Bt) + (size_t)nxt.pn * tstepB : cB;
        for (int t = 0; t < nt; t += 2) {
            const bool last = (t == nt - 2);
            const char* a1 = cA + (size_t)(t + 1) * kstep;
            const char* a2 = last ? nA : cA + (size_t)(t + 2) * kstep; const char* b2 = last ? nB : cB + (size_t)(t + 2) * kstep;
            const char* a3 = a2 + kstep; const char* b3 = b2 + kstep;
            if (last && has_next) S.a_ready(nxt);
            if constexpr (SP2) {
            PG8_LDB(B0, 0, 0); PG8_LDB(B1, 0, 1); PG8_SCHED; PG8_LDA(At, 0, 0); PG8_STAGE(PG8_SA(1, 1), a1 + hstepA, voffA);
            PG8_WAIT_V(8); PG8_WAIT_L(0); PG8_BAR; PG8_MMA(0, 0, At, B0); PG8_MMA(0, 1, At, B1); PG8_BAR; PG8_SCHED;
            PG8_LDA(At, 0, 1); PG8_STAGE(PG8_SB(0, 0), b2, voffB); PG8_STAGE(PG8_SB(0, 1), b2 + hstepB, voffB); PG8_STAGE(PG8_SA(0, 0), a2, voffA);
            PG8_WAIT_V(8); PG8_WAIT_L(0); PG8_BAR; PG8_MMA(1, 0, At, B0); PG8_MMA(1, 1, At, B1); PG8_BAR; PG8_SCHED;
            PG8_LDB(B0, 1, 0); PG8_LDB(B1, 1, 1); PG8_SCHED; PG8_LDA(At, 1, 0); PG8_STAGE(PG8_SA(0, 1), a2 + hstepA, voffA);
            PG8_WAIT_V(8); PG8_WAIT_L(0); PG8_BAR; PG8_MMA(0, 0, At, B0); PG8_MMA(0, 1, At, B1); PG8_BAR; PG8_SCHED;
            PG8_LDA(At, 1, 1); PG8_STAGE(PG8_SB(1, 0), b3, voffB); PG8_STAGE(PG8_SB(1, 1), b3 + hstepB, voffB); PG8_STAGE(PG8_SA(1, 0), a3, voffA);
            PG8_WAIT_V(8); PG8_WAIT_L(0); PG8_BAR; PG8_MMA(1, 0, At, B0); PG8_MMA(1, 1, At, B1); PG8_BAR; PG8_SCHED;
            } else {
            PG8_LDB(B0, 0, 0); PG8_SCHED; PG8_LDA(At, 0, 0); PG8_STAGE(PG8_SA(1, 1), a1 + hstepA, voffA);
            PG8_WAIT_L(8); PG8_BAR; PG8_WAIT_L(0); PG8_MMA(0, 0, At, B0); PG8_BAR; PG8_SCHED;
            PG8_LDB(B1, 0, 1); PG8_STAGE(PG8_SB(0, 0), b2, voffB);
            PG8_BAR; PG8_WAIT_L(0); PG8_MMA(0, 1, At, B1); PG8_BAR;
            PG8_LDA(At, 0, 1); PG8_STAGE(PG8_SA(0, 0), a2, voffA);
            PG8_BAR; PG8_WAIT_L(0); PG8_MMA(1, 0, At, B0); PG8_BAR; PG8_SCHED;
            PG8_STAGE(PG8_SB(0, 1), b2 + hstepB, voffB);
            PG8_WAIT_V(6); PG8_BAR; PG8_MMA(1, 1, At, B1); PG8_BAR;
            PG8_LDB(B0, 1, 0); PG8_SCHED; PG8_LDA(At, 1, 0); PG8_STAGE(PG8_SA(0, 1), a2 + hstepA, voffA);
            PG8_WAIT_L(8); PG8_BAR; PG8_WAIT_L(0); PG8_MMA(0, 0, At, B0); PG8_BAR; PG8_SCHED;
            PG8_LDB(B1, 1, 1); PG8_STAGE(PG8_SB(1, 0), b3, voffB);
            PG8_BAR; PG8_WAIT_L(0); PG8_MMA(0, 1, At, B1); PG8_BAR;
            PG8_LDA(At, 1, 1); PG8_STAGE(PG8_SA(1, 0), a3, voffA);
            PG8_BAR; PG8_WAIT_L(0); PG8_MMA(1, 0, At, B0); PG8_BAR; PG8_SCHED;
            PG8_STAGE(PG8_SB(1, 1), b3 + hstepB, voffB);
            PG8_WAIT_V(6); PG8_BAR; PG8_MMA(1, 1, At, B1); PG8_BAR;
            }
        }
        if constexpr (ALIGN_EPI) { if (wr == 0) PG8_BAR; }
        if constexpr (!Epi::AFTER_DRAIN) { E(acc, cur, wr, wc, fr, fq); S.done(cur); }
        if (!has_next) break;
        if (!Epi::DUAL || cur.sel == 1) {
#pragma unroll
        for (int a = 0; a < 2; ++a)
#pragma unroll
            for (int b = 0; b < 2; ++b)
#pragma unroll
                for (int m = 0; m < 4; ++m)
#pragma unroll
                    for (int n = 0; n < 2; ++n) acc[a][b][m][n] = (f32x4){0.f, 0.f, 0.f, 0.f};
        }
        cur = nxt; cA = nA; cB = nB; ++ui;
        if constexpr (ALIGN_EPI) { if (wr == 1) PG8_BAR; }
    }
    PG8_WAIT_V(0);
    if constexpr (!ALIGN_EPI) { if (wr == 0) PG8_BAR; }
    PG8_BAR;
    if constexpr (Epi::AFTER_DRAIN) { E.fused(acc, cur, wr, wc, fr, fq, lds, wid, lane); S.done(cur); }
#undef PG8_SA
#undef PG8_SB
#undef PG8_STAGE
#undef PG8_LDA
#undef PG8_LDB
#undef PG8_MMA
#undef PG8_WAIT_V
#undef PG8_WAIT_L
#undef PG8_BAR
#undef PG8_SCHED
}
}

#define LAS __attribute__((address_space(3)))
typedef unsigned short bf16_t;
typedef short bf16x8 __attribute__((ext_vector_type(8)));
typedef short s16x4 __attribute__((ext_vector_type(4)));
typedef float f32x4 __attribute__((ext_vector_type(4)));
typedef float f32x16 __attribute__((ext_vector_type(16)));
typedef unsigned u32x4 __attribute__((ext_vector_type(4)));
typedef unsigned u32x2 __attribute__((ext_vector_type(2)));

constexpr int DM = 1024, MP = 65536, MS_ = 32768, MT = 98304, SP = 8192, SS = 16384, DFF = 2816;
constexpr int NIN = 3840;
constexpr float EPSN = 1e-6f;
constexpr float LOG2E = 1.4426950408889634f;
constexpr float QS_NA = 0.125f * LOG2E;
constexpr float QS_M = 0.10206207261596575f * LOG2E;

constexpr size_t MiB = 1u << 20;
constexpr size_t W_IN = 0, W_VNA = W_IN + (size_t)NIN * 1024 * 2, W_UQ = W_VNA + 512 * 1024 * 2, W_UK = W_UQ + 768 * 384 * 2, W_UV = W_UK + 512 * 256 * 2,
                 W_NAO = W_UV + 512 * 256 * 2, W_MLAO = W_NAO + 1024 * 512 * 2, W_OUT = W_MLAO + 1024 * 512 * 2, W_GU = W_OUT + 1024 * 1024 * 2,
                 W_DN = W_GU + (size_t)5632 * 1024 * 2, W_PG = W_DN + (size_t)1024 * 2816 * 2, W_PL = W_PG + 1024 * 1024 * 2, W_END = W_PL + 1024 * 256 * 2;
static_assert(W_END <= 34 * MiB, "weights region");
constexpr size_t WS_CTL = 33 * MiB, CTL_BYTES = 16384;
static_assert(W_END <= WS_CTL, "ctl after weights");
constexpr size_t WS_ROPE = 34 * MiB;
constexpr size_t WS_RSQ = 36 * MiB;
constexpr size_t WS_KROPE = 38 * MiB;
constexpr size_t WS_PB = 44 * MiB;
constexpr size_t WS_XN = 92 * MiB;
constexpr size_t WS_QNA = 284 * MiB, WS_KNA = 380 * MiB, WS_VTNA = 476 * MiB;
constexpr size_t WS_ZLAT = 572 * MiB;
constexpr size_t WS_ZQN = 716 * MiB, WS_ZKVN = 788 * MiB;
constexpr size_t WS_QM = 92 * MiB;
constexpr size_t WS_KN = 716 * MiB;
constexpr size_t WS_VTM = 836 * MiB;
constexpr size_t WS_MLAO = 572 * MiB;
constexpr size_t WS_T1 = 92 * MiB;
constexpr size_t WS_U = 380 * MiB;
constexpr size_t WS_XB1 = 92 * MiB;
constexpr size_t WS_H = 284 * MiB;
constexpr size_t WS_XB2 = 92 * MiB;
constexpr size_t WS_PW = 284 * MiB;
constexpr size_t WS_NEED = 932 * MiB;

#ifndef PHASES
#define PHASES 0x7ff
#endif
constexpr int LDS_BYTES = 147456;

struct Params {
    const float *x_p, *x_s, *p_p, *p_s, *g_mix, *w_in, *rpb, *g_q, *w_uq, *g_kv, *w_ukv, *w_nao, *w_mlao, *w_out, *g_ffn, *w_gu, *w_dn, *g_ple, *w_pg, *w_pl, *g_fin;
    float* out; unsigned char* ws;
};

__device__ __forceinline__ unsigned pk2(float lo, float hi) { return pg8::cvt_pk_bf16(lo, hi); }
__device__ __forceinline__ float bf2f(unsigned short b) { return __uint_as_float((unsigned)b << 16); }
__device__ __forceinline__ float bflo(unsigned w) { return __uint_as_float(w << 16); }
__device__ __forceinline__ float bfhi(unsigned w) { return __uint_as_float(w & 0xffff0000u); }
__device__ __forceinline__ float sigmoidf_(float x) { return __builtin_amdgcn_rcpf(1.0f + __builtin_amdgcn_exp2f(-x * LOG2E)); }
__device__ __forceinline__ void store8(bf16_t* p, f32x4 a, f32x4 b) { u32x4 w; w.x = pk2(a[0], a[1]); w.y = pk2(a[2], a[3]); w.z = pk2(b[0], b[1]); w.w = pk2(b[2], b[3]); *(u32x4*)p = w; }
__device__ __forceinline__ float wave_sum(float v) {
#pragma unroll
    for (int o = 1; o < 64; o <<= 1) v += __shfl_xor(v, o);
    return v;
}
__device__ __forceinline__ int opq(int v) { asm volatile("" : "+s"(v)); return v; }
__device__ __forceinline__ int my_lane() { int l; asm volatile("v_mbcnt_lo_u32_b32 %0, -1, 0\n\tv_mbcnt_hi_u32_b32 %0, -1, %0" : "=v"(l)); return l; }
__device__ __forceinline__ int row_pos(int row) { return row < MP ? (row & (SP - 1)) : (row & (SS - 1)); }

typedef f32x4 Acc[2][2][4][2];
#define EPI_ROWS(ai, m) (u.pm * 256 + (ai) * 128 + wr * 64 + (m) * 16 + fr)
#define EPI_COL(bj) (u.pn * 256 + (bj) * 128 + wc * 32 + 8 * fq)

__device__ __forceinline__ void rowsum_atomic4(float* dst, const float (&ss)[4], int row0  , int fq) {
    const float v = fq == 0 ? ss[0] : fq == 1 ? ss[1] : fq == 2 ? ss[2] : ss[3];
    unsafeAtomicAdd(dst + row0 + 16 * fq, v);
}
struct EpiIn {
    static constexpr bool PERM = true, AFTER_DRAIN = false, DUAL = false;
    bf16_t *qna, *kna, *gates, *zlat; float *rsq_q, *rsq_kv;
    __device__ __forceinline__ void operator()(const Acc& acc, const pg8::Unit& u, int wr, int wc, int fr, int fq) const {
        const int pn = u.pn; bf16_t* base; int ldc, cb, mode;
        if (pn < 2) { base = qna; ldc = 512; cb = pn * 256; mode = 1; }
        else if (pn < 4) { base = kna; ldc = 512; cb = (pn - 2) * 256; mode = 0; }
        else if (pn < 12) { base = gates; ldc = 2048; cb = (pn - 4) * 256; mode = 2; }
        else { base = zlat; ldc = 768; cb = (pn - 12) * 256; mode = 0; }
        const float sc = mode == 1 ? QS_NA : 1.0f;
#pragma unroll
        for (int ai = 0; ai < 2; ++ai) { float sq[4] = {0.f, 0.f, 0.f, 0.f}, sk[4] = {0.f, 0.f, 0.f, 0.f};
#pragma unroll
            for (int m = 0; m < 4; ++m) {
                bf16_t* rowp = base + (size_t)EPI_ROWS(ai, m) * ldc + cb + wc * 32 + 8 * fq;
#pragma unroll
                for (int bj = 0; bj < 2; ++bj) {
                    f32x4 v0 = acc[ai][bj][m][0], v1 = acc[ai][bj][m][1];
                    if (mode == 2) {
#pragma unroll
                        for (int e = 0; e < 4; ++e) { v0[e] = sigmoidf_(v0[e]); v1[e] = sigmoidf_(v1[e]); }
                    } else { v0 = v0 * sc; v1 = v1 * sc; }
                    store8(rowp + bj * 128, v0, v1);
                    if (pn >= 12) {
                        const bool isq = (pn == 12 || (pn == 13 && bj == 0)), iskv = !isq && (pn == 13 || bj == 0);
                        if (isq || iskv) { float ss = (v0[0] * v0[0] + v0[1] * v0[1]) + (v0[2] * v0[2] + v0[3] * v0[3]) + (v1[0] * v1[0] + v1[1] * v1[1]) + (v1[2] * v1[2] + v1[3] * v1[3]);
                            ss += __shfl_xor(ss, 16); ss += __shfl_xor(ss, 32);
                            if (isq) sq[m] += ss; else sk[m] += ss; }
                    }
                }
            }
            if (pn >= 12) { if (pn <= 13) rowsum_atomic4(rsq_q, sq, EPI_ROWS(ai, 0), fq); if (pn >= 13) rowsum_atomic4(rsq_kv, sk, EPI_ROWS(ai, 0), fq); }
        }
    }
};
struct EpiPlain {
    static constexpr bool PERM = true, AFTER_DRAIN = false, DUAL = false;
    bf16_t* O; int ldc;
    __device__ __forceinline__ void operator()(const Acc& acc, const pg8::Unit& u, int wr, int wc, int fr, int fq) const {
#pragma unroll
        for (int ai = 0; ai < 2; ++ai)
#pragma unroll
            for (int m = 0; m < 4; ++m) {
                bf16_t* rowp = O + (size_t)EPI_ROWS(ai, m) * ldc + EPI_COL(0);
#pragma unroll
                for (int bj = 0; bj < 2; ++bj) store8(rowp + bj * 128, acc[ai][bj][m][0], acc[ai][bj][m][1]);
            }
    }
};
struct EpiPlainPermT {
    static constexpr bool PERM = true, AFTER_DRAIN = false, DUAL = false;
    bf16_t* O; int ldc;
    __device__ __forceinline__ void operator()(const Acc& acc, const pg8::Unit& u, int wr, int wc, int fr, int fq) const {
#pragma unroll
        for (int bj = 0; bj < 2; ++bj) { const int col = EPI_COL(bj);
#pragma unroll
            for (int ai = 0; ai < 2; ++ai)
#pragma unroll
                for (int m = 0; m < 4; ++m) { const f32x4 v0 = acc[ai][bj][m][0], v1 = acc[ai][bj][m][1];
                    bf16_t* p = O + (size_t)EPI_ROWS(ai, m) * ldc + (col & ~15) + ((col & 8) ? 4 : 0);
                    u32x2 w0, w1; w0.x = pk2(v0[0], v0[1]); w0.y = pk2(v0[2], v0[3]); w1.x = pk2(v1[0], v1[1]); w1.y = pk2(v1[2], v1[3]);
                    *(u32x2*)p = w0; *(u32x2*)(p + 8) = w1; } }
    }
};
struct EpiRowScale {
    static constexpr bool PERM = true, AFTER_DRAIN = false, DUAL = false;
    bf16_t* O; int ldc; const float* rsq; float invn;
    __device__ __forceinline__ void operator()(const Acc& acc, const pg8::Unit& u, int wr, int wc, int fr, int fq) const {
        float rq[2][4];
#pragma unroll
        for (int ai = 0; ai < 2; ++ai)
#pragma unroll
            for (int m = 0; m < 4; ++m) rq[ai][m] = rsq[EPI_ROWS(ai, m)];
#pragma unroll
        for (int ai = 0; ai < 2; ++ai)
#pragma unroll
            for (int m = 0; m < 4; ++m) {
                const float rstd = __builtin_amdgcn_rsqf(rq[ai][m] * invn + EPSN);
                bf16_t* rowp = O + (size_t)EPI_ROWS(ai, m) * ldc + EPI_COL(0);
#pragma unroll
                for (int bj = 0; bj < 2; ++bj) store8(rowp + bj * 128, acc[ai][bj][m][0] * rstd, acc[ai][bj][m][1] * rstd);
            }
    }
};
struct EpiColScale {
    static constexpr bool PERM = true, AFTER_DRAIN = false, DUAL = false;
    bf16_t* O; int ldc; const float* rsq; float invn;
    __device__ __forceinline__ void operator()(const Acc& acc, const pg8::Unit& u, int wr, int wc, int fr, int fq) const {
#pragma unroll
        for (int bj = 0; bj < 2; ++bj) {
            const int col = EPI_COL(bj);
            f32x4 r0 = *(const f32x4*)(rsq + col), r1 = *(const f32x4*)(rsq + col + 4);
#pragma unroll
            for (int e = 0; e < 4; ++e) { r0[e] = __builtin_amdgcn_rsqf(r0[e] * invn + EPSN); r1[e] = __builtin_amdgcn_rsqf(r1[e] * invn + EPSN); }
#pragma unroll
            for (int ai = 0; ai < 2; ++ai)
#pragma unroll
                for (int m = 0; m < 4; ++m) {
                    const f32x4 v0 = acc[ai][bj][m][0] * r0, v1 = acc[ai][bj][m][1] * r1;
                    bf16_t* p = O + (size_t)EPI_ROWS(ai, m) * ldc + (col & ~15) + ((col & 8) ? 4 : 0);
                    u32x2 w0, w1; w0.x = pk2(v0[0], v0[1]); w0.y = pk2(v0[2], v0[3]); w1.x = pk2(v1[0], v1[1]); w1.y = pk2(v1[2], v1[3]);
                    *(u32x2*)p = w0; *(u32x2*)(p + 8) = w1; }
        }
    }
};
struct EpiQRope {
    static constexpr bool PERM = true, AFTER_DRAIN = false, DUAL = false;
    bf16_t* Qm; const float2* tab; const float* rsq;
    __device__ __forceinline__ void operator()(const Acc& acc, const pg8::Unit& u, int wr, int wc, int fr, int fq) const {
        const bool rope0 = ((u.pn * 8 + wc) % 3) == 2, rope1 = ((u.pn * 8 + 4 + wc) % 3) == 2, anyrope = rope0 || rope1;
#pragma unroll
        for (int ai = 0; ai < 2; ++ai) {
            f32x4 cs[4][2]; float rq[4];
#pragma unroll
            for (int m = 0; m < 4; ++m) rq[m] = rsq[EPI_ROWS(ai, m)];
            if (anyrope) {
#pragma unroll
                for (int m = 0; m < 4; ++m) { const f32x4* t = (const f32x4*)(tab + (size_t)row_pos(EPI_ROWS(ai, m)) * 16 + 4 * fq); cs[m][0] = t[0]; cs[m][1] = t[1]; }
            }
#pragma unroll
            for (int m = 0; m < 4; ++m) {
                const int row = EPI_ROWS(ai, m);
#pragma unroll
                for (int bj = 0; bj < 2; ++bj) {
                    const float sc = QS_M * __builtin_amdgcn_rsqf(rq[m] * (1.0f / 384.0f) + EPSN);
                    f32x4 v0 = acc[ai][bj][m][0] * sc, v1 = acc[ai][bj][m][1] * sc;
                    if (bj == 0 ? rope0 : rope1) {
#pragma unroll
                        for (int e = 0; e < 4; ++e) { const float cc = cs[m][e >> 1][2 * (e & 1)], sn = cs[m][e >> 1][2 * (e & 1) + 1]; const float a = v0[e], b = v1[e]; v0[e] = a * cc - b * sn; v1[e] = b * cc + a * sn; }
                    }
                    store8(Qm + (size_t)row * 768 + EPI_COL(bj), v0, v1);
                }
            }
            asm volatile("" ::: "memory");
        }
    }
};
struct EpiGateDual {
    static constexpr bool PERM = true, AFTER_DRAIN = false, DUAL = true;
    bf16_t* U; const bf16_t* gates;
    __device__ __forceinline__ void operator()(Acc& acc, const pg8::Unit& u, int wr, int wc, int fr, int fq) const {
        if (u.sel == 0) {
#pragma unroll
            for (int ai = 0; ai < 2; ++ai)
#pragma unroll
                for (int mp = 0; mp < 2; ++mp) {
                    u32x4 ga[2][2], gb[2][2];
#pragma unroll
                    for (int mm = 0; mm < 2; ++mm)
#pragma unroll
                        for (int bj = 0; bj < 2; ++bj) { const bf16_t* gp = gates + (size_t)EPI_ROWS(ai, 2 * mp + mm) * 2048 + EPI_COL(bj); ga[mm][bj] = *(const u32x4*)gp; gb[mm][bj] = *(const u32x4*)(gp + 1024); }
#pragma unroll
                    for (int mm = 0; mm < 2; ++mm)
#pragma unroll
                        for (int bj = 0; bj < 2; ++bj) { const int m = 2 * mp + mm; const u32x4 a = ga[mm][bj], b = gb[mm][bj];
#define RATIO_(x, y) ((x) * __builtin_amdgcn_rcpf(fmaxf((y), 1e-30f)))
                            acc[ai][bj][m][0][0] *= RATIO_(bflo(a.x), bflo(b.x)); acc[ai][bj][m][0][1] *= RATIO_(bfhi(a.x), bfhi(b.x)); acc[ai][bj][m][0][2] *= RATIO_(bflo(a.y), bflo(b.y)); acc[ai][bj][m][0][3] *= RATIO_(bfhi(a.y), bfhi(b.y));
                            acc[ai][bj][m][1][0] *= RATIO_(bflo(a.z), bflo(b.z)); acc[ai][bj][m][1][1] *= RATIO_(bfhi(a.z), bfhi(b.z)); acc[ai][bj][m][1][2] *= RATIO_(bflo(a.w), bflo(b.w)); acc[ai][bj][m][1][3] *= RATIO_(bfhi(a.w), bfhi(b.w));
#undef RATIO_
                        }
                    asm volatile("" ::: "memory");
                }
        } else {
#pragma unroll
            for (int ai = 0; ai < 2; ++ai) {
                u32x4 g[4][2];
#pragma unroll
                for (int m = 0; m < 4; ++m)
#pragma unroll
                    for (int bj = 0; bj < 2; ++bj) g[m][bj] = *(const u32x4*)(gates + (size_t)EPI_ROWS(ai, m) * 2048 + 1024 + EPI_COL(bj));
#pragma unroll
                for (int m = 0; m < 4; ++m)
#pragma unroll
                    for (int bj = 0; bj < 2; ++bj) { const u32x4 gg = g[m][bj];
                        f32x4 v0 = acc[ai][bj][m][0], v1 = acc[ai][bj][m][1];
                        v0[0] *= bflo(gg.x); v0[1] *= bfhi(gg.x); v0[2] *= bflo(gg.y); v0[3] *= bfhi(gg.y);
                        v1[0] *= bflo(gg.z); v1[1] *= bfhi(gg.z); v1[2] *= bflo(gg.w); v1[3] *= bfhi(gg.w);
                        store8(U + (size_t)EPI_ROWS(ai, m) * 1024 + EPI_COL(bj), v0, v1); }
                asm volatile("" ::: "memory");
            }
        }
    }
};
template <bool BASE_BF16> struct EpiResid {
    static constexpr bool PERM = true, AFTER_DRAIN = false, DUAL = false;
    const float* base_p; const float* base_s;
    const bf16_t* base_b; bf16_t* XB; float* rowsq;
    __device__ __forceinline__ void operator()(const Acc& acc, const pg8::Unit& u, int wr, int wc, int fr, int fq) const {
#pragma unroll
        for (int ai = 0; ai < 2; ++ai) { float ssv[4];
#pragma unroll
            for (int mp = 0; mp < 2; ++mp) {
                f32x4 b[2][2][2];
#pragma unroll
                for (int mm = 0; mm < 2; ++mm) { const int row = EPI_ROWS(ai, 2 * mp + mm);
                    if (BASE_BF16) {
#pragma unroll
                        for (int bj = 0; bj < 2; ++bj) { const u32x4 t = *(const u32x4*)(base_b + (size_t)row * 1024 + EPI_COL(bj));
                            b[mm][bj][0] = (f32x4){bflo(t.x), bfhi(t.x), bflo(t.y), bfhi(t.y)}; b[mm][bj][1] = (f32x4){bflo(t.z), bfhi(t.z), bflo(t.w), bfhi(t.w)}; }
                    } else {
                        const float* brow = row < MP ? base_p + (size_t)row * 1024 : base_s + (size_t)(row - MP) * 1024;
#pragma unroll
                        for (int bj = 0; bj < 2; ++bj) { b[mm][bj][0] = *(const f32x4*)(brow + EPI_COL(bj)); b[mm][bj][1] = *(const f32x4*)(brow + EPI_COL(bj) + 4); }
                    } }
#pragma unroll
                for (int mm = 0; mm < 2; ++mm) { const int m = 2 * mp + mm, row = EPI_ROWS(ai, m); float ss = 0.f;
#pragma unroll
                    for (int bj = 0; bj < 2; ++bj) { const int col = EPI_COL(bj);
                        const f32x4 v0 = acc[ai][bj][m][0] + b[mm][bj][0], v1 = acc[ai][bj][m][1] + b[mm][bj][1];
                        store8(XB + (size_t)row * 1024 + col, v0, v1);
                        ss += (v0[0] * v0[0] + v0[1] * v0[1]) + (v0[2] * v0[2] + v0[3] * v0[3]) + (v1[0] * v1[0] + v1[1] * v1[1]) + (v1[2] * v1[2] + v1[3] * v1[3]); }
                    ss += __shfl_xor(ss, 16); ss += __shfl_xor(ss, 32);
                    ssv[m] = ss; }
                asm volatile("" ::: "memory");
            }
            rowsum_atomic4(rowsq, ssv, EPI_ROWS(ai, 0), fq); }
    }
};
struct EpiGLU {
    static constexpr bool PERM = true, AFTER_DRAIN = false, DUAL = false;
    bf16_t* H; const float* rowsq;
    __device__ __forceinline__ void operator()(const Acc& acc, const pg8::Unit& u, int wr, int wc, int fr, int fq) const {
        float rq[2][4];
#pragma unroll
        for (int ai = 0; ai < 2; ++ai)
#pragma unroll
            for (int m = 0; m < 4; ++m) rq[ai][m] = rowsq[EPI_ROWS(ai, m)];
#pragma unroll
        for (int ai = 0; ai < 2; ++ai)
#pragma unroll
            for (int m = 0; m < 4; ++m) {
                const int row = EPI_ROWS(ai, m);
                const float rstd = __builtin_amdgcn_rsqf(rq[ai][m] * (1.0f / 1024.0f) + EPSN);
                f32x4 hv[2];
#pragma unroll
                for (int bj = 0; bj < 2; ++bj) {
                    const f32x4 g = acc[ai][bj][m][0] * rstd, up = acc[ai][bj][m][1] * rstd;
#pragma unroll
                    for (int e = 0; e < 4; ++e) hv[bj][e] = g[e] * sigmoidf_(g[e]) * up[e];
                }
                store8(H + (size_t)row * DFF + u.pn * 128 + wc * 32 + 8 * fq, hv[0], hv[1]);
            }
    }
};
struct EpiPle {
    static constexpr bool PERM = true, AFTER_DRAIN = false, DUAL = false;
    const bf16_t* X2B; bf16_t* X3B; const bf16_t* PW; const float* rowsq2; float* rowsq3;
    __device__ __forceinline__ void operator()(const Acc& acc, const pg8::Unit& u, int wr, int wc, int fr, int fq) const {
        float rq[2][4];
#pragma unroll
        for (int ai = 0; ai < 2; ++ai)
#pragma unroll
            for (int m = 0; m < 4; ++m) rq[ai][m] = rowsq2[EPI_ROWS(ai, m)];
#pragma unroll
        for (int ai = 0; ai < 2; ++ai) { float ssv[4];
#pragma unroll
            for (int mp = 0; mp < 2; ++mp) {
                u32x4 xb[2][2], t[2][2];
#pragma unroll
                for (int mm = 0; mm < 2; ++mm)
#pragma unroll
                    for (int bj = 0; bj < 2; ++bj) { const size_t off = (size_t)EPI_ROWS(ai, 2 * mp + mm) * 1024 + EPI_COL(bj);
                        xb[mm][bj] = *(const u32x4*)(X2B + off); t[mm][bj] = *(const u32x4*)(PW + off); }
#pragma unroll
                for (int mm = 0; mm < 2; ++mm) { const int m = 2 * mp + mm, row = EPI_ROWS(ai, m);
                    const float rstd = __builtin_amdgcn_rsqf(rq[ai][m] * (1.0f / 1024.0f) + EPSN); float ss = 0.f;
#pragma unroll
                    for (int bj = 0; bj < 2; ++bj) {
                        const u32x4 bb = xb[mm][bj], tt = t[mm][bj];
                        const f32x4 a0 = acc[ai][bj][m][0] * rstd, a1 = acc[ai][bj][m][1] * rstd;
                        f32x4 v0, v1;
                        v0[0] = bflo(bb.x) + sigmoidf_(a0[0]) * bflo(tt.x); v0[1] = bfhi(bb.x) + sigmoidf_(a0[1]) * bfhi(tt.x); v0[2] = bflo(bb.y) + sigmoidf_(a0[2]) * bflo(tt.y); v0[3] = bfhi(bb.y) + sigmoidf_(a0[3]) * bfhi(tt.y);
                        v1[0] = bflo(bb.z) + sigmoidf_(a1[0]) * bflo(tt.z); v1[1] = bfhi(bb.z) + sigmoidf_(a1[1]) * bfhi(tt.z); v1[2] = bflo(bb.w) + sigmoidf_(a1[2]) * bflo(tt.w); v1[3] = bfhi(bb.w) + sigmoidf_(a1[3]) * bfhi(tt.w);
                        store8(X3B + (size_t)row * 1024 + EPI_COL(bj), v0, v1);
                        ss += (v0[0] * v0[0] + v0[1] * v0[1]) + (v0[2] * v0[2] + v0[3] * v0[3]) + (v1[0] * v1[0] + v1[1] * v1[1]) + (v1[2] * v1[2] + v1[3] * v1[3]); }
                    ss += __shfl_xor(ss, 16); ss += __shfl_xor(ss, 32);
                    ssv[m] = ss; }
                asm volatile("" ::: "memory");
            }
            rowsum_atomic4(rowsq3, ssv, EPI_ROWS(ai, 0), fq); }
    }
};

constexpr int A_K0 = 0, A_KB = 13312, A_V0 = 4 * A_KB, A_VB = 9216, A_TBL = A_V0 + 4 * A_VB + 1024;
static_assert(A_TBL + 465 * 4 < 131072, "attention LDS");

__device__ __forceinline__ float max3f(float a, float b, float c) { float r; asm("v_max3_f32 %0, %1, %2, %3" : "=v"(r) : "v"(a), "v"(b), "v"(c)); return r; }
__device__ __forceinline__ float rowmax32(const f32x16& p0, const f32x16& p1) {
    float a = max3f(p0[0], p0[1], p1[0]), b = max3f(p0[2], p0[3], p1[1]); a = max3f(a, p1[2], p1[3]);
#pragma unroll
    for (int r = 4; r < 16; r += 4) { a = max3f(a, p0[r], p0[r + 1]); b = max3f(b, p0[r + 2], p0[r + 3]); a = max3f(a, p1[r], p1[r + 1]); b = max3f(b, p1[r + 2], p1[r + 3]); }
    const float m = fmaxf(a, b);
    auto rr = __builtin_amdgcn_permlane32_swap(__float_as_uint(m), __float_as_uint(m), false, false);
    return fmaxf(__uint_as_float(rr[0]), __uint_as_float(rr[1]));
}
__device__ __forceinline__ void glds16(const void* gsrc, unsigned lds_dst) { unsigned keep;
    asm volatile("s_mov_b32 %0, m0\n\ts_mov_b32 m0, %2\n\ts_nop 0\n\tglobal_load_lds_dwordx4 %1, off\n\ts_mov_b32 m0, %0" : "=&s"(keep) : "v"(gsrc), "s"(lds_dst) : "memory"); }
template <int LO, int HI> __device__ __forceinline__ void g_exp(f32x16& X) {
#pragma unroll
    for (int r = LO; r < HI; ++r) X[r] = __builtin_amdgcn_exp2f(X[r]);
}
template <int LO, int HI> __device__ __forceinline__ void g_sumpk(const f32x16& X, float& psa, float& psb, u32x4& pwlo, u32x4& pwhi) {
#pragma unroll
    for (int r = LO; r < HI; r += 2) { psa += X[r]; psb += X[r + 1]; const unsigned w = pk2(X[r], X[r + 1]); if (r < 8) pwlo[(r >> 1) & 3] = w; else pwhi[(r >> 1) & 3] = w; }
    asm volatile("" : "+v"(psa), "+v"(psb));
}
constexpr float A_THR = 8.0f;

template <bool NA>
__device__ __forceinline__ void attn_unit(LAS unsigned char* lds, const bf16_t* Q, const bf16_t* Kg, const bf16_t* Kr, const bf16_t* Vt, bf16_t* O,
                                          int h, int seqrow0, int q0, int t0, int NT, int rows, int g0, const float* rpb_h, int wid) {
    constexpr int DQK = NA ? 64 : 96, NJ = DQK / 16, KP = DQK + 8, QPITCH = NA ? 512 : 768;
    const int lane = my_lane(), tid = wid * 64 + lane, r32 = lane & 31, hi = lane >> 5;
    const int kvr = tid >> 3, c8 = tid & 7;
    const bf16_t* ksrc = Kg + (size_t)(seqrow0 + t0 * 64 + kvr) * 512 + h * 64 + 8 * c8;
    const bf16_t* rsrc = NA ? nullptr : Kr + (size_t)(seqrow0 + t0 * 64 + (tid >> 2)) * 32 + 8 * (tid & 3);
    const bf16_t* vsrc = Vt + (size_t)(h * 64 + kvr) * MT + seqrow0 + t0 * 64 + 8 * c8;
    const unsigned kdst = A_K0 + (kvr * KP + 8 * c8) * 2, rdst = A_K0 + ((tid >> 2) * KP + 64 + 8 * (tid & 3)) * 2, vdst = A_V0 + (kvr * 72 + 16 * (c8 >> 1) + 4 * (c8 & 1)) * 2;
    u32x4 rk, rr, rv;
#define A_LOADK(t) do { const int tt_ = (t) < NT ? (t) : NT - 1; const size_t ro = (size_t)(tt_ * 64); rk = *(const u32x4*)(ksrc + ro * 512); if (!NA && tid < 256) rr = *(const u32x4*)(rsrc + ro * 32); } while (0)
#define A_LOADV(t) do { const int tt_ = (t) < NT ? (t) : NT - 1; rv = *(const u32x4*)(vsrc + (size_t)(tt_ * 64)); } while (0)
#define A_STOREK(b) do { *(LAS u32x4*)(lds + kdst + (b) * A_KB) = rk; if (!NA && tid < 256) *(LAS u32x4*)(lds + rdst + (b) * A_KB) = rr; } while (0)
#define A_STOREV(b) do { *(LAS u32x2*)(lds + vdst + (b) * A_VB) = (u32x2){rv.x, rv.y}; *(LAS u32x2*)(lds + vdst + (b) * A_VB + 16) = (u32x2){rv.z, rv.w}; } while (0)
    int g = 0, rs = 0, c = 0, cs = 0;
    if (NA) {
        g = g0 + (wid >> 1); rs = g - 4; rs = rs < 0 ? 0 : (rs > rows - 8 ? rows - 8 : rs);
        c = 32 * (wid & 1) + r32; cs = c - 8; cs = cs < 0 ? 0 : (cs > 48 ? 48 : cs);
        LAS float* tbl = (LAS float*)(lds + A_TBL);
        if (tid < 465) tbl[tid] = rpb_h[tid] * LOG2E;
    }
    const unsigned lds_u = (unsigned)(uintptr_t)lds;
    const char* dk_src[2] = {nullptr, nullptr}; unsigned dk_str[2] = {0u, 0u}; const char* dv_src[2] = {nullptr, nullptr};
    {
        constexpr int CPR = NA ? 9 : 13;
#pragma unroll
        for (int j = 0; j < 2; ++j) { const int ci = 64 * (wid + 8 * j) + lane, row = (ci / CPR) & 63, col = ci % CPR;
            const bool rope = !NA && (col >= 8 && col < 12);
            dk_src[j] = rope ? (const char*)(Kr + (size_t)(seqrow0 + t0 * 64 + row) * 32 + 8 * (col - 8)) : (const char*)(Kg + (size_t)(seqrow0 + t0 * 64 + row) * 512 + h * 64 + 8 * (col & 7));
            dk_str[j] = rope ? 64u * 64u : 64u * 1024u; }
#pragma unroll
        for (int j = 0; j < 2; ++j) { const int ci = 64 * (wid + 8 * j) + lane, row = ci / 9, col = ci - 9 * row;
            dv_src[j] = (const char*)(Vt + (size_t)(h * 64 + (row & 63)) * MT + seqrow0 + t0 * 64 + 8 * (col & 7)); }
    }
#define A_DMAK(t, slot) do { const unsigned tt_ = (unsigned)((t) < NT ? (t) : NT - 1); \
        glds16(dk_src[0] + (size_t)tt_ * dk_str[0], (unsigned)__builtin_amdgcn_readfirstlane(lds_u + A_K0 + (slot) * A_KB + wid * 1024)); \
        if (NA ? wid == 0 : wid < 5) glds16(dk_src[1] + (size_t)tt_ * dk_str[1], (unsigned)__builtin_amdgcn_readfirstlane(lds_u + A_K0 + (slot) * A_KB + (wid + 8) * 1024)); } while (0)
#define A_DMAV(t, slot) do { const unsigned tt_ = (unsigned)((t) < NT ? (t) : NT - 1); \
        glds16(dv_src[0] + (size_t)tt_ * 128u, (unsigned)__builtin_amdgcn_readfirstlane(lds_u + A_V0 + (slot) * A_VB + wid * 1024)); \
        if (wid == 0) glds16(dv_src[1] + (size_t)tt_ * 128u, (unsigned)__builtin_amdgcn_readfirstlane(lds_u + A_V0 + (slot) * A_VB + 8 * 1024)); } while (0)
    const size_t qrow = (size_t)(seqrow0 + q0 + wid * 32 + r32);
    bf16x8 qr[NJ];
#pragma unroll
    for (int j = 0; j < NJ; ++j) qr[j] = *(const bf16x8*)(Q + qrow * QPITCH + h * DQK + 16 * j + 8 * hi);
    f32x16 o0, o1, negm;
#pragma unroll
    for (int r = 0; r < 16; ++r) { o0[r] = 0.f; o1[r] = 0.f; negm[r] = 0.f; }
    float mref = 0.f, lrun = 0.f;
    const LAS unsigned char* kfb = lds + A_K0 + (r32 * KP + 8 * hi) * 2;
    const LAS unsigned char* vfb = lds + A_V0 + (r32 * 72 + 8 * hi) * 2;
#define A_QK(N0, N1, b) do { const LAS unsigned char* kp_ = kfb + (b) * A_KB; \
        _Pragma("unroll") for (int j = 0; j < NJ; ++j) { \
            const bf16x8 a0_ = *(const LAS bf16x8*)(kp_ + j * 32), a1_ = *(const LAS bf16x8*)(kp_ + 32 * KP * 2 + j * 32); \
            N0 = __builtin_amdgcn_mfma_f32_32x32x16_bf16(a0_, qr[j], j == 0 ? negm : N0, 0, 0, 0); \
            N1 = __builtin_amdgcn_mfma_f32_32x32x16_bf16(a1_, qr[j], j == 0 ? negm : N1, 0, 0, 0); } } while (0)
#define A_MASK(N0, N1, t) do { if (NA) { const int kr_ = t0 + (t); const bool act_ = (kr_ >= rs) && (kr_ < rs + 8) && ((t) < NT); \
        const LAS float* tb_ = (const LAS float*)(lds + A_TBL) + ((act_ ? kr_ - g + 7 : 0) * 31 + 15 - c + 4 * hi); const int kb_ = act_ ? 4 * hi - cs : -1000; \
        _Pragma("unroll") for (int r = 0; r < 16; ++r) { const int kc0 = (r & 3) + 8 * (r >> 2), kc1 = kc0 + 32; const float b0_ = tb_[kc0], b1_ = tb_[kc1]; \
            N0[r] = ((unsigned)(kb_ + kc0) < 16u) ? N0[r] + b0_ : -INFINITY; N1[r] = ((unsigned)(kb_ + kc1) < 16u) ? N1[r] + b1_ : -INFINITY; } } } while (0)
#define A_SB() __builtin_amdgcn_sched_barrier(0)
#define A_QKG(N0, N1, j) do { bf16x8 kn0_ = kf0_, kn1_ = kf1_; \
        if ((j) + 1 < NJ) { kn0_ = *(const LAS bf16x8*)(kp_ + ((j) + 1) * 32); kn1_ = *(const LAS bf16x8*)(kp_ + 32 * KP * 2 + ((j) + 1) * 32); } \
        else { kn0_ = *(const LAS bf16x8*)(vp_); kn1_ = *(const LAS bf16x8*)(vp_ + 32 * 144); } \
        N0 = __builtin_amdgcn_mfma_f32_32x32x16_bf16(kf0_, qr[j], (j) == 0 ? negm : N0, 0, 0, 0); \
        N1 = __builtin_amdgcn_mfma_f32_32x32x16_bf16(kf1_, qr[j], (j) == 0 ? negm : N1, 0, 0, 0); \
        kf0_ = kn0_; kf1_ = kn1_; } while (0)
#define A_PVG(blk) do { bf16x8 kn0_ = kf0_, kn1_ = kf1_; \
        if ((blk) + 1 < 4) { kn0_ = *(const LAS bf16x8*)(vp_ + ((blk) + 1) * 32); kn1_ = *(const LAS bf16x8*)(vp_ + 32 * 144 + ((blk) + 1) * 32); } \
        const bf16x8 pb_ = __builtin_bit_cast(bf16x8, pw_[blk]); \
        o0 = __builtin_amdgcn_mfma_f32_32x32x16_bf16(kf0_, pb_, o0, 0, 0, 0); \
        o1 = __builtin_amdgcn_mfma_f32_32x32x16_bf16(kf1_, pb_, o1, 0, 0, 0); \
        kf0_ = kn0_; kf1_ = kn1_; } while (0)
#define A_STEP(C0, C1, TMC, N0, N1, TMN, t) do { \
        const LAS unsigned char* kp_ = kfb + (((t) + 1) & 3) * A_KB; const LAS unsigned char* vp_ = vfb + ((t) & 3) * A_VB; \
        bf16x8 kf0_ = *(const LAS bf16x8*)(kp_), kf1_ = *(const LAS bf16x8*)(kp_ + 32 * KP * 2); \
        { const bool first_ = NA ? (t0 + (t) == rs) : ((t) == 0); \
          if (first_ || __any(TMC > A_THR)) { const float dl_ = first_ ? (TMC > -1e20f ? TMC : 0.f) : fmaxf(TMC, 0.f); mref += dl_; const float f_ = __builtin_amdgcn_exp2f(-dl_); lrun *= f_; \
              _Pragma("unroll") for (int r = 0; r < 16; ++r) { o0[r] *= f_; o1[r] *= f_; C0[r] -= dl_; C1[r] -= dl_; negm[r] = -mref; } } } \
        A_DMAK((t) + 3, ((t) + 3) & 3); A_DMAV((t) + 2, ((t) + 2) & 3); \
        u32x4 pw_[4]; float psa_ = 0.f, psb_ = 0.f; \
        A_SB(); \
        if constexpr (!NA) { \
            A_QKG(N0, N1, 0); g_exp<0, 6>(C0); A_SB(); \
            A_QKG(N0, N1, 1); g_exp<6, 12>(C0); g_sumpk<0, 6>(C0, psa_, psb_, pw_[0], pw_[1]); A_SB(); \
            A_QKG(N0, N1, 2); g_exp<12, 16>(C0); g_sumpk<6, 12>(C0, psa_, psb_, pw_[0], pw_[1]); A_SB(); \
            A_QKG(N0, N1, 3); g_exp<0, 6>(C1); g_sumpk<12, 16>(C0, psa_, psb_, pw_[0], pw_[1]); A_SB(); \
            A_QKG(N0, N1, 4); g_exp<6, 12>(C1); g_sumpk<0, 6>(C1, psa_, psb_, pw_[2], pw_[3]); A_SB(); \
            A_QKG(N0, N1, 5); g_exp<12, 16>(C1); g_sumpk<6, 12>(C1, psa_, psb_, pw_[2], pw_[3]); A_SB(); \
            A_PVG(0); g_sumpk<12, 16>(C1, psa_, psb_, pw_[2], pw_[3]); A_SB(); \
        } else { \
            A_QKG(N0, N1, 0); g_exp<0, 8>(C0); A_SB(); \
            A_QKG(N0, N1, 1); g_exp<8, 16>(C0); g_sumpk<0, 8>(C0, psa_, psb_, pw_[0], pw_[1]); A_SB(); \
            A_QKG(N0, N1, 2); g_exp<0, 8>(C1); g_sumpk<8, 16>(C0, psa_, psb_, pw_[0], pw_[1]); A_SB(); \
            A_QKG(N0, N1, 3); g_exp<8, 16>(C1); g_sumpk<0, 8>(C1, psa_, psb_, pw_[2], pw_[3]); A_SB(); \
            A_PVG(0); g_sumpk<8, 16>(C1, psa_, psb_, pw_[2], pw_[3]); A_SB(); \
        } \
        A_PVG(1); A_MASK(N0, N1, (t) + 1); A_SB(); \
        A_PVG(2); TMN = rowmax32(N0, N1); A_SB(); \
        A_PVG(3); lrun += psa_ + psb_; \
        A_SB(); \
        if ((t) & 1) { asm volatile("s_waitcnt vmcnt(0)" ::: "memory"); __syncthreads(); } } while (0)

#define A_MASKR(X, r, kcoff) do { const int kc_ = ((r) & 3) + 8 * ((r) >> 2) + (kcoff); const float b_ = tb_[kc_]; X[r] = ((unsigned)(kb_ + kc_) < 16u) ? X[r] + b_ : -INFINITY; } while (0)
#define A_PVB(blk) do { const bf16x8 va0 = *(const LAS bf16x8*)(vp_ + (blk) * 32), va1 = *(const LAS bf16x8*)(vp_ + 32 * 144 + (blk) * 32); const bf16x8 pb_ = __builtin_bit_cast(bf16x8, pw_[blk]); \
        o0 = __builtin_amdgcn_mfma_f32_32x32x16_bf16(va0, pb_, o0, 0, 0, 0); o1 = __builtin_amdgcn_mfma_f32_32x32x16_bf16(va1, pb_, o1, 0, 0, 0); } while (0)
#define A_STEP_NA(C0, C1, TMC, N0, N1, TMN, t) do { \
        const int krc_ = t0 + (t); const bool actc_ = (krc_ >= rs) && (krc_ < rs + 8), actn_ = (krc_ + 1 >= rs) && (krc_ + 1 < rs + 8) && ((t) + 1 < NT); \
        A_DMAK((t) + 3, ((t) + 3) & 3); A_DMAV((t) + 2, ((t) + 2) & 3); \
        if (actc_) { const bool first_ = (krc_ == rs); \
          if (first_ || __any(TMC > A_THR)) { const float dl_ = first_ ? TMC : fmaxf(TMC, 0.f); mref += dl_; const float f_ = __builtin_amdgcn_exp2f(-dl_); lrun *= f_; \
              _Pragma("unroll") for (int r = 0; r < 16; ++r) { o0[r] *= f_; o1[r] *= f_; C0[r] -= dl_; C1[r] -= dl_; negm[r] = -mref; } } } \
        if (actn_) { A_QK(N0, N1, ((t) + 1) & 3); \
            const LAS float* tb_ = (const LAS float*)(lds + A_TBL) + ((krc_ + 1 - g + 7) * 31 + 15 - c + 4 * hi); const int kb_ = 4 * hi - cs; \
            if ((wid & 1) == 0) { \
                _Pragma("unroll") for (int r = 0; r < 16; ++r) A_MASKR(N0, r, 0); \
                _Pragma("unroll") for (int r = 0; r < 4; ++r) A_MASKR(N1, r, 32); \
                _Pragma("unroll") for (int r = 4; r < 16; ++r) N1[r] = -INFINITY; \
            } else { \
                _Pragma("unroll") for (int r = 0; r < 12; ++r) N0[r] = -INFINITY; \
                _Pragma("unroll") for (int r = 12; r < 16; ++r) A_MASKR(N0, r, 0); \
                _Pragma("unroll") for (int r = 0; r < 16; ++r) A_MASKR(N1, r, 32); \
            } \
            TMN = rowmax32(N0, N1); } \
        if (actc_) { float ps_ = 0.f; u32x4 pw_[4]; const LAS unsigned char* vp_ = vfb + ((t) & 3) * A_VB; \
            if ((wid & 1) == 0) { \
                _Pragma("unroll") for (int r = 0; r < 16; ++r) { C0[r] = __builtin_amdgcn_exp2f(C0[r]); ps_ += C0[r]; } \
                _Pragma("unroll") for (int r = 0; r < 4; ++r) { C1[r] = __builtin_amdgcn_exp2f(C1[r]); ps_ += C1[r]; } \
                pw_[0] = (u32x4){pk2(C0[0], C0[1]), pk2(C0[2], C0[3]), pk2(C0[4], C0[5]), pk2(C0[6], C0[7])}; \
                pw_[1] = (u32x4){pk2(C0[8], C0[9]), pk2(C0[10], C0[11]), pk2(C0[12], C0[13]), pk2(C0[14], C0[15])}; \
                pw_[2] = (u32x4){pk2(C1[0], C1[1]), pk2(C1[2], C1[3]), 0u, 0u}; \
                A_PVB(0); A_PVB(1); A_PVB(2); \
            } else { \
                _Pragma("unroll") for (int r = 12; r < 16; ++r) { C0[r] = __builtin_amdgcn_exp2f(C0[r]); ps_ += C0[r]; } \
                _Pragma("unroll") for (int r = 0; r < 16; ++r) { C1[r] = __builtin_amdgcn_exp2f(C1[r]); ps_ += C1[r]; } \
                pw_[1] = (u32x4){0u, 0u, pk2(C0[12], C0[13]), pk2(C0[14], C0[15])}; \
                pw_[2] = (u32x4){pk2(C1[0], C1[1]), pk2(C1[2], C1[3]), pk2(C1[4], C1[5]), pk2(C1[6], C1[7])}; \
                pw_[3] = (u32x4){pk2(C1[8], C1[9]), pk2(C1[10], C1[11]), pk2(C1[12], C1[13]), pk2(C1[14], C1[15])}; \
                A_PVB(1); A_PVB(2); A_PVB(3); \
            } \
            lrun += ps_; } \
        if ((t) & 1) { asm volatile("s_waitcnt vmcnt(0)" ::: "memory"); __syncthreads(); } } while (0)

    { A_DMAK(0, 0); A_DMAV(0, 0); A_DMAK(1, 1); A_DMAK(2, 2); A_DMAV(1, 1); }
    asm volatile("s_waitcnt vmcnt(0)" ::: "memory");
    __syncthreads();
    f32x16 sA0, sA1, sB0, sB1; float tmA, tmB;
    A_QK(sA0, sA1, 0);
    A_MASK(sA0, sA1, 0);
    tmA = rowmax32(sA0, sA1);
    __syncthreads();
    if constexpr (NA) {
        for (int t = 0; t < NT; t += 2) {
            A_STEP_NA(sA0, sA1, tmA, sB0, sB1, tmB, t);
            if (t + 1 < NT) A_STEP_NA(sB0, sB1, tmB, sA0, sA1, tmA, t + 1);
        }
        if (NT & 1) { asm volatile("s_waitcnt vmcnt(0)" ::: "memory"); __syncthreads(); }
    } else {
        for (int t = 0; t < NT; t += 2) {
            A_STEP(sA0, sA1, tmA, sB0, sB1, tmB, t);
            A_STEP(sB0, sB1, tmB, sA0, sA1, tmA, t + 1);
        }
    }
    const float lt = lrun + __shfl_xor(lrun, 32);
    const float inv = 1.0f / lt;
    bf16_t* orow = O + qrow * 512 + h * 64 + 4 * hi;
#pragma unroll
    for (int gq = 0; gq < 4; ++gq) {
        u32x2 w0, w1;
        w0.x = pk2(o0[4 * gq] * inv, o0[4 * gq + 1] * inv); w0.y = pk2(o0[4 * gq + 2] * inv, o0[4 * gq + 3] * inv);
        w1.x = pk2(o1[4 * gq] * inv, o1[4 * gq + 1] * inv); w1.y = pk2(o1[4 * gq + 2] * inv, o1[4 * gq + 3] * inv);
        *(u32x2*)(orow + 8 * gq) = w0; *(u32x2*)(orow + 32 + 8 * gq) = w1;
    }
#undef A_LOADK
#undef A_LOADV
#undef A_STOREK
#undef A_STOREV
#undef A_QK
#undef A_MASK
#undef A_STEP
#undef A_DMAK
#undef A_DMAV
#undef A_STEP_NA
#undef A_MASKR
#undef A_PVB
#undef A_SB
#undef A_QKG
#undef A_PVG
}

template <class Map>
__device__ __forceinline__ void transpose_item(const float* W, int ldw, int K, int N, bf16_t* WT, const float* gain, LAS float* scr, int item, int lane, Map map) {
    const int nblk = N / 32, kb = item / nblk, nb = item % nblk, k0 = 64 * kb, n0 = 32 * nb;
    const int src = map(n0 + (lane & 31));
#pragma unroll 8
    for (int i = 0; i < 32; ++i) { const int kk = 2 * i + (lane >> 5); float v = 0.f; if (src >= 0) { v = W[(size_t)(k0 + kk) * ldw + src]; if (gain) v *= gain[k0 + kk]; } scr[kk * 33 + (lane & 31)] = v; }
    asm volatile("s_waitcnt lgkmcnt(0)" ::: "memory");
    const int c = lane & 7;
#pragma unroll
    for (int j = 0; j < 4; ++j) { const int n = (lane >> 3) + 8 * j; const LAS float* s = scr + (8 * c) * 33 + n;
        u32x4 o; o.x = pk2(s[0 * 33], s[1 * 33]); o.y = pk2(s[2 * 33], s[3 * 33]); o.z = pk2(s[4 * 33], s[5 * 33]); o.w = pk2(s[6 * 33], s[7 * 33]);
        *(u32x4*)(WT + (size_t)(n0 + n) * K + k0 + 8 * c) = o; }
    asm volatile("s_waitcnt lgkmcnt(0)" ::: "memory");
}
__device__ __forceinline__ float2 rope_cs(int pos, int i) {
    const int a = i & 3, b = i >> 2;
    const double cf = a == 0 ? 1.0 : a == 1 ? 0.5623413251903491 : a == 2 ? 0.31622776601683794 : 0.1778279410038923;
    const double sf = b == 0 ? 1.0 : b == 1 ? 0.1 : b == 2 ? 0.01 : 0.001;
    double rev = (double)pos * (cf * sf) * 0.15915494309189535;
    rev -= __builtin_floor(rev);
    const float fr = (float)rev;
    return make_float2(__builtin_amdgcn_cosf(fr), __builtin_amdgcn_sinf(fr));
}
__device__ __forceinline__ int rope_perm(int p) { return 16 * ((p >> 2) & 1) + 4 * (p >> 3) + (p & 3); }

#define XB_TMO      128
#define XB_XCNT(j)  (256  + 64 * (j))
#define XB_XSUB(j)  (1280 + 64 * (j))
#define XB_XGEN(j)  (2304 + 64 * (j))
#define XB_TOP      3328
#define XB_TOPGEN   3392
#define XCD_BAR_WORDS 3456
#define XB_SPIN_CAP (1u << 18)

__device__ __forceinline__ unsigned xb_ld(unsigned* p)              { return __hip_atomic_load(p, __ATOMIC_RELAXED, __HIP_MEMORY_SCOPE_AGENT); }
__device__ __forceinline__ unsigned xb_add(unsigned* p, unsigned v) { return __hip_atomic_fetch_add(p, v, __ATOMIC_RELAXED, __HIP_MEMORY_SCOPE_AGENT); }
__device__ __forceinline__ unsigned xb_xcc_id() { return (unsigned)__builtin_amdgcn_s_getreg((3 << 11) | 20) & 0xFu; }
#define XB_SPIN(cond, bar) do { unsigned _sp = 0; while (cond) { __builtin_amdgcn_s_sleep(1); \
    if ((++_sp & 255u) == 0u) { if (xb_ld(&(bar)[XB_TMO])) break; if (_sp > XB_SPIN_CAP) { atomicAdd(&(bar)[XB_TMO], 1u); break; } } } } while (0)

struct XcdBarrier {
    unsigned* bar; unsigned x;
    volatile LAS unsigned* st;
};

__device__ __forceinline__ XcdBarrier xcd_barrier_post(unsigned* bar, volatile LAS unsigned* st) {
    XcdBarrier b; b.bar = bar; b.x = xb_xcc_id(); b.st = st;
    if (threadIdx.x == 0) (void)xb_add(&bar[XB_XCNT(b.x)], 1u);
    return b;
}
__device__ __forceinline__ void xcd_barrier_complete(unsigned* bar, unsigned x, unsigned& nloc, unsigned& nx) {
    const unsigned G = gridDim.x * gridDim.y * gridDim.z;
    unsigned sum, cnt, mine, sp = 0u;
    for (;;) {
        sum = 0u; cnt = 0u; mine = 0u;
#pragma unroll
        for (unsigned j = 0; j < 16; ++j) { const unsigned c = xb_ld(&bar[XB_XCNT(j)]); sum += c; cnt += (c > 0u) ? 1u : 0u; mine = (j == x) ? c : mine; }
        if (sum == G) break;
        __builtin_amdgcn_s_sleep(1);
        if ((++sp & 255u) == 0u) { if (xb_ld(&bar[XB_TMO])) break; if (sp > XB_SPIN_CAP) { atomicAdd(&bar[XB_TMO], 1u); break; } }
    }
    nloc = mine > 0u ? mine : 1u; nx = cnt > 0u ? cnt : 1u;
}

__device__ __forceinline__ void xcd_barrier(const XcdBarrier& b) {
    asm volatile("s_waitcnt vmcnt(0)" ::: "memory");
    __syncthreads();
    if (threadIdx.x == 0) {
        unsigned* bar = b.bar;
        __builtin_amdgcn_s_waitcnt(0);
        unsigned nloc = b.st[0], nx = b.st[1];
        if (nloc == 0u) { xcd_barrier_complete(bar, b.x, nloc, nx); b.st[0] = nloc; b.st[1] = nx; }
        const unsigned old = xb_add(&bar[XB_XSUB(b.x)], 1u);
        const unsigned gen = old / nloc;
        if (old + 1u == (gen + 1u) * nloc) {
            __builtin_amdgcn_fence(__ATOMIC_RELEASE, "agent");
            asm volatile("s_waitcnt vmcnt(0)" ::: "memory");
            const unsigned og = xb_add(&bar[XB_TOP], 1u);
            const unsigned tg = og / nx;
            if (og + 1u == (tg + 1u) * nx) xb_add(&bar[XB_TOPGEN], 1u);
            else XB_SPIN(xb_ld(&bar[XB_TOPGEN]) == tg, bar);
            __builtin_amdgcn_fence(__ATOMIC_ACQUIRE, "agent");
            xb_add(&bar[XB_XGEN(b.x)], 1u);
            asm volatile("s_waitcnt vmcnt(0)" ::: "memory");
        } else {
            XB_SPIN(xb_ld(&bar[XB_XGEN(b.x)]) == gen, bar);
            __builtin_amdgcn_fence(__ATOMIC_ACQUIRE, "agent");
            asm volatile("s_waitcnt vmcnt(0)" ::: "memory");
        }
    }
    __syncthreads();
}

#define Wt_in ((bf16_t*)(kp->ws + W_IN))
#define Wt_vna ((bf16_t*)(kp->ws + W_VNA))
#define Wt_uq ((bf16_t*)(kp->ws + W_UQ))
#define Wt_uk ((bf16_t*)(kp->ws + W_UK))
#define Wt_uv ((bf16_t*)(kp->ws + W_UV))
#define Wt_nao ((bf16_t*)(kp->ws + W_NAO))
#define Wt_mlao ((bf16_t*)(kp->ws + W_MLAO))
#define Wt_out ((bf16_t*)(kp->ws + W_OUT))
#define Wt_gu ((bf16_t*)(kp->ws + W_GU))
#define Wt_dn ((bf16_t*)(kp->ws + W_DN))
#define Wt_pg ((bf16_t*)(kp->ws + W_PG))
#define Wt_pl ((bf16_t*)(kp->ws + W_PL))
#define ropetab ((float2*)(kp->ws + WS_ROPE))
#define rsq1 ((float*)(kp->ws + WS_RSQ))
#define krope ((bf16_t*)(kp->ws + WS_KROPE))
#define PB ((bf16_t*)(kp->ws + WS_PB))
#define XN ((bf16_t*)(kp->ws + WS_XN))
#define QNA ((bf16_t*)(kp->ws + WS_QNA))
#define KNA ((bf16_t*)(kp->ws + WS_KNA))
#define VTNA ((bf16_t*)(kp->ws + WS_VTNA))
#define ZLAT ((bf16_t*)(kp->ws + WS_ZLAT))
#define ZQN ((bf16_t*)(kp->ws + WS_ZQN))
#define ZKVN ((bf16_t*)(kp->ws + WS_ZKVN))
#define QM ((bf16_t*)(kp->ws + WS_QM))
#define KN ((bf16_t*)(kp->ws + WS_KN))
#define VTM ((bf16_t*)(kp->ws + WS_VTM))
#define MLAO ((bf16_t*)(kp->ws + WS_MLAO))
#define T1 ((bf16_t*)(kp->ws + WS_T1))
#define U ((bf16_t*)(kp->ws + WS_U))
#define XB1 ((bf16_t*)(kp->ws + WS_XB1))
#define HB ((bf16_t*)(kp->ws + WS_H))
#define XB2 ((bf16_t*)(kp->ws + WS_XB2))
#define PW ((bf16_t*)(kp->ws + WS_PW))
#define X3B ((bf16_t*)(kp->ws + 476 * MiB))
#define rsqQ (rsq1 + 3 * MT)
#define rsqKV (rsq1 + 4 * MT)
#define rsq2 (rsq1 + MT)
#define rsq3 (rsq1 + 2 * MT)
#define NAO QNA
#define GATES ((bf16_t*)kp->out)

typedef const __attribute__((address_space(4))) Params KParams;
__device__ __forceinline__ KParams* kparams() { unsigned long long p = (unsigned long long)__builtin_amdgcn_kernarg_segment_ptr(); asm volatile("" : "+s"(p)); return (KParams*)p; }
#define KP_RELOAD kp = kparams()
__global__ void __launch_bounds__(512, 2) fwd_kernel(Params P) {
    extern __shared__ __attribute__((aligned(16))) unsigned char lds_raw[];
    LAS unsigned char* lds = (LAS unsigned char*)lds_raw;
    cg::grid_group grid = cg::this_grid();
    const KParams* kp;
    KP_RELOAD;
    { volatile LAS unsigned* st0 = (volatile LAS unsigned*)(lds + LDS_BYTES - 64); if (threadIdx.x < 16) st0[threadIdx.x] = 0u; __syncthreads(); }
    const XcdBarrier xbar = xcd_barrier_post((unsigned*)(kp->ws + WS_CTL), (volatile LAS unsigned*)(lds + LDS_BYTES - 64));

    const int wave = __builtin_amdgcn_readfirstlane(threadIdx.x >> 6);
    const int G = gridDim.x, bx = blockIdx.x;
    const int vcu = (G % 8 == 0) ? (bx % 8) * (G / 8) + bx / 8 : bx;
    const int gw = vcu * 8 + wave, NGW = G * 8;
    KP_RELOAD;
    if constexpr (PHASES & 1) {
        const int lane = my_lane();
        LAS float* scr = (LAS float*)(lds + wave * 16384);
        constexpr int I_IN = 16 * (NIN / 32), I_VNA = 16 * 16, I_UQ = 6 * 24, I_UK = 4 * 16, I_UV = 4 * 16, I_NAO = 8 * 32, I_MLAO = 8 * 32, I_OUT = 16 * 32, I_GU = 16 * 176, I_DN = 44 * 32, I_PG = 16 * 32, I_PL = 4 * 32;
        constexpr int NITEMS = I_IN + I_VNA + I_UQ + I_UK + I_UV + I_NAO + I_MLAO + I_OUT + I_GU + I_DN + I_PG + I_PL;
        for (int it = gw; it < NITEMS; it += NGW) {
            int r = it;
            if (r < I_IN) { transpose_item(kp->w_in, 4256, 1024, NIN, Wt_in, nullptr, scr, r, lane, [](int n) { if (n < 1024) return n; if (n < 3072) return 2208 + (n - 1024); const int t = n - 3072; return t < 672 ? 1536 + t : -1; }); continue; } r -= I_IN;
            if (r < I_VNA) { transpose_item(kp->w_in, 4256, 1024, 512, Wt_vna, nullptr, scr, r, lane, [](int n) { return 1024 + n; }); continue; } r -= I_VNA;
            if (r < I_UQ) { transpose_item(kp->w_uq, 768, 384, 768, Wt_uq, kp->g_q, scr, r, lane, [](int n) { const int hh = n / 96, rr = n % 96; return rr < 64 ? n : hh * 96 + 64 + rope_perm(rr - 64); }); continue; } r -= I_UQ;
            if (r < I_UK) { transpose_item(kp->w_ukv, 1024, 256, 512, Wt_uk, kp->g_kv, scr, r, lane, [](int n) { return (n >> 6) * 128 + (n & 63); }); continue; } r -= I_UK;
            if (r < I_UV) { transpose_item(kp->w_ukv, 1024, 256, 512, Wt_uv, kp->g_kv, scr, r, lane, [](int n) { return (n >> 6) * 128 + 64 + (n & 63); }); continue; } r -= I_UV;
            if (r < I_NAO) { transpose_item(kp->w_nao, 1024, 512, 1024, Wt_nao, nullptr, scr, r, lane, [](int n) { return n; }); continue; } r -= I_NAO;
            if (r < I_MLAO) { transpose_item(kp->w_mlao, 1024, 512, 1024, Wt_mlao, nullptr, scr, r, lane, [](int n) { return n; }); continue; } r -= I_MLAO;
            if (r < I_OUT) { transpose_item(kp->w_out, 1024, 1024, 1024, Wt_out, nullptr, scr, r, lane, [](int n) { return n; }); continue; } r -= I_OUT;
            if (r < I_GU) { transpose_item(kp->w_gu, 5632, 1024, 5632, Wt_gu, kp->g_ffn, scr, r, lane, [](int n) { const int nt_ = n & 255, j = (n >> 8) * 128 + 32 * ((nt_ >> 5) & 3) + 8 * ((nt_ >> 3) & 3) + 4 * (nt_ >> 7) + (nt_ & 3); return ((nt_ >> 2) & 1) ? DFF + j : j; }); continue; } r -= I_GU;
            if (r < I_DN) { transpose_item(kp->w_dn, 1024, 2816, 1024, Wt_dn, nullptr, scr, r, lane, [](int n) { return n; }); continue; } r -= I_DN;
            if (r < I_PG) { transpose_item(kp->w_pg, 1024, 1024, 1024, Wt_pg, kp->g_ple, scr, r, lane, [](int n) { return n; }); continue; } r -= I_PG;
            transpose_item(kp->w_pl, 1024, 256, 1024, Wt_pl, nullptr, scr, r, lane, [](int n) { return n; });
        }
        {
            f32x4 gmix[4];
#pragma unroll
            for (int j = 0; j < 4; ++j) gmix[j] = *(const f32x4*)(kp->g_mix + 4 * lane + 256 * j);
            for (int m0 = gw; m0 < MT; m0 += 4 * NGW) {
                f32x4 v[4][4], pv[4];
#pragma unroll
                for (int u = 0; u < 4; ++u) { const int m = m0 + u * NGW < MT ? m0 + u * NGW : m0;
                    const float* xr = m < MP ? kp->x_p + (size_t)m * 1024 : kp->x_s + (size_t)(m - MP) * 1024;
                    const float* pr = m < MP ? kp->p_p + (size_t)m * 256 : kp->p_s + (size_t)(m - MP) * 256;
#pragma unroll
                    for (int j = 0; j < 4; ++j) v[u][j] = *(const f32x4*)(xr + 4 * lane + 256 * j);
                    pv[u] = *(const f32x4*)(pr + 4 * lane); }
#pragma unroll
                for (int u = 0; u < 4; ++u) { const int m = m0 + u * NGW < MT ? m0 + u * NGW : m0; float s = 0.f;
#pragma unroll
                    for (int j = 0; j < 4; ++j) s += (v[u][j][0] * v[u][j][0] + v[u][j][1] * v[u][j][1]) + (v[u][j][2] * v[u][j][2] + v[u][j][3] * v[u][j][3]);
                    const float rstd = __builtin_amdgcn_rsqf(wave_sum(s) * (1.0f / 1024.0f) + EPSN);
#pragma unroll
                    for (int j = 0; j < 4; ++j) { const f32x4 gg = gmix[j]; u32x2 w; w.x = pk2(v[u][j][0] * rstd * gg[0], v[u][j][1] * rstd * gg[1]); w.y = pk2(v[u][j][2] * rstd * gg[2], v[u][j][3] * rstd * gg[3]);
                        *(u32x2*)(XN + (size_t)m * 1024 + 4 * lane + 256 * j) = w; }
                    u32x2 w; w.x = pk2(pv[u][0], pv[u][1]); w.y = pk2(pv[u][2], pv[u][3]);
                    *(u32x2*)(PB + (size_t)m * 256 + 4 * lane) = w; }
            }
        }
        for (int i = gw * 64 + lane; i < SS * 16; i += NGW * 64) ropetab[i] = rope_cs(i >> 4, i & 15);
        for (int i = gw * 64 + lane; i < 5 * MT; i += NGW * 64) rsq1[i] = 0.f;
    }
    if (kp->ws == nullptr) grid.sync();
    xcd_barrier(xbar);

    KP_RELOAD;
    if constexpr (PHASES & 2) {
        pg8::Gemm g{XN, Wt_in, MT, NIN, opq(1024)}; pg8::StaticOrder S; S.init(MT, NIN, G, bx);
        EpiIn E{QNA, KNA, GATES, ZLAT, rsqQ, rsqKV};
        pg8::gemm_phase<EpiIn, pg8::StaticOrder, true, true>(lds, g, S, E, wave * 64 + my_lane());
        pg8::Gemm g2{Wt_vna, XN, 512, MT, opq(1024)}; pg8::StaticOrder S2; S2.init(512, MT, G, bx);
        EpiPlainPermT E2{VTNA, MT};
        pg8::gemm_phase<EpiPlainPermT, pg8::StaticOrder, true, true>(lds, g2, S2, E2, wave * 64 + my_lane());
    }
    xcd_barrier(xbar);

    KP_RELOAD;
    if constexpr (PHASES & 8) {
        for (int i0 = gw * 64 + my_lane(); i0 < MT * 16; i0 += 4 * NGW * 64) {
            float x1[4], x2[4]; float2 cs[4];
#pragma unroll
            for (int u = 0; u < 4; ++u) { const int i = i0 + u * NGW * 64 < MT * 16 ? i0 + u * NGW * 64 : i0; const int m = i >> 4, ii = i & 15;
                const bf16_t* zr = ZLAT + (size_t)m * 768 + 640; x1[u] = bf2f(zr[ii]); x2[u] = bf2f(zr[16 + ii]); cs[u] = ropetab[(size_t)row_pos(m) * 16 + ii]; }
#pragma unroll
            for (int u = 0; u < 4; ++u) { const int i = i0 + u * NGW * 64 < MT * 16 ? i0 + u * NGW * 64 : i0; const int m = i >> 4, ii = i & 15;
                bf16_t* ko = krope + (size_t)m * 32 + 8 * (ii >> 2) + (ii & 3);
                ko[0] = (bf16_t)(pk2(x1[u] * cs[u].x - x2[u] * cs[u].y, 0.f) & 0xffffu); ko[4] = (bf16_t)(pk2(x2[u] * cs[u].x + x1[u] * cs[u].y, 0.f) & 0xffffu); }
        }
        pg8::Gemm g{ZLAT, Wt_uq, MT, 768, opq(384), 768, 0}; pg8::StaticOrder S; S.init(MT, 768, G, bx);
        EpiQRope E{QM, ropetab, rsqQ};
        pg8::gemm_phase<EpiQRope, pg8::StaticOrder, true, true>(lds, g, S, E, wave * 64 + my_lane());
        pg8::Gemm g2{ZLAT + 384, Wt_uk, MT, 512, opq(256), 768, 0}; pg8::StaticOrder S2; S2.init(MT, 512, G, bx);
        EpiRowScale E2{KN, 512, rsqKV, 1.0f / 256.0f};
        pg8::gemm_phase<EpiRowScale, pg8::StaticOrder, true, true>(lds, g2, S2, E2, wave * 64 + my_lane());
        pg8::Gemm g3{Wt_uv, ZLAT + 384, 512, MT, opq(256), 0, 768}; pg8::StaticOrder S3; S3.init(512, MT, G, bx);
        EpiColScale E3{VTM, MT, rsqKV, 1.0f / 256.0f};
        pg8::gemm_phase<EpiColScale, pg8::StaticOrder, true, true>(lds, g3, S3, E3, wave * 64 + my_lane());
    }
    xcd_barrier(xbar);

    KP_RELOAD;
    if constexpr (PHASES & 16) {
        for (int u = vcu; u < 3072; u += G) {
            int seqrow0, h, rg, rows;
            if (u < 2048) { seqrow0 = (u >> 8) * SP; h = (u >> 5) & 7; rg = u & 31; rows = 128; }
            else { const int v = u - 2048; seqrow0 = MP + (v >> 9) * SS; h = (v >> 6) & 7; rg = v & 63; rows = 256; }
            const int g0 = 4 * rg;
            int lo = g0 - 4; lo = lo < 0 ? 0 : (lo > rows - 8 ? rows - 8 : lo);
            int hi_ = g0 - 1; hi_ = hi_ < 0 ? 0 : (hi_ > rows - 8 ? rows - 8 : hi_); hi_ += 7;
            attn_unit<true>(lds, QNA, KNA, nullptr, VTNA, NAO, h, seqrow0, 256 * rg, lo, hi_ - lo + 1, rows, g0, kp->rpb + h * 465, wave);
        }
        for (int u = vcu; u < 2048; u += G) {
            const int pair = u >> 5, qb = u & 31;
            attn_unit<false>(lds, QM, KN, krope, VTM, MLAO, pair & 7, (pair >> 3) * SP, 256 * qb, 0, SP / 64, 0, 0, nullptr, wave);
        }
        for (int u = vcu; u < 1024; u += G) {
            const int pair = u >> 6, qb = u & 63;
            attn_unit<false>(lds, QM, KN, krope, VTM, MLAO, pair & 7, MP + (pair >> 3) * SS, 256 * qb, 0, SS / 64, 0, 0, nullptr, wave);
        }
    }
    xcd_barrier(xbar);

    KP_RELOAD;
    if constexpr (PHASES & 32) {
        pg8::Gemm g{NAO, Wt_nao, MT, 1024, opq(512), 0, 0, MLAO, Wt_mlao}; pg8::DualOrder S; S.b.init(MT, 1024, G, bx);
        EpiGateDual E{U, GATES};
        pg8::gemm_phase<EpiGateDual, pg8::DualOrder, true, true>(lds, g, S, E, wave * 64 + my_lane());
    }
    xcd_barrier(xbar);

    KP_RELOAD;
    if constexpr (PHASES & 64) {
        pg8::Gemm g{U, Wt_out, MT, 1024, opq(1024)}; pg8::StaticOrder S; S.init(MT, 1024, G, bx);
        EpiResid<false> E{kp->x_p, kp->x_s, nullptr, XB1, rsq1};
        pg8::gemm_phase<EpiResid<false>, pg8::StaticOrder, true, true>(lds, g, S, E, wave * 64 + my_lane());
    }
    xcd_barrier(xbar);

    KP_RELOAD;
    if constexpr (PHASES & 128) {
        pg8::Gemm g{XB1, Wt_gu, MT, 5632, opq(1024)}; pg8::StaticOrder S; S.init(MT, 5632, G, bx);
        EpiGLU E{HB, rsq1};
        pg8::gemm_phase<EpiGLU, pg8::StaticOrder, true, true>(lds, g, S, E, wave * 64 + my_lane());
    }
    xcd_barrier(xbar);

    KP_RELOAD;
    if constexpr (PHASES & 256) {
        pg8::Gemm g{HB, Wt_dn, MT, 1024, opq(DFF)}; pg8::StaticOrder S; S.init(MT, 1024, G, bx);
        EpiResid<true> E{nullptr, nullptr, XB1, XB2, rsq2};
        pg8::gemm_phase<EpiResid<true>, pg8::StaticOrder, true, true>(lds, g, S, E, wave * 64 + my_lane());
    }
    xcd_barrier(xbar);

    KP_RELOAD;
    if constexpr (PHASES & 512) {
        pg8::Gemm g{PB, Wt_pl, MT, 1024, opq(256)}; pg8::StaticOrder S; S.init(MT, 1024, G, bx);
        EpiPlain E{PW, 1024};
        pg8::gemm_phase<EpiPlain, pg8::StaticOrder, true, true>(lds, g, S, E, wave * 64 + my_lane());
        pg8::Gemm g2{XB2, Wt_pg, MT, 1024, opq(1024)};
        EpiPle E2{XB2, X3B, PW, rsq2, rsq3};
        pg8::gemm_phase<EpiPle, pg8::StaticOrder, true, true>(lds, g2, S, E2, wave * 64 + my_lane());
    }
    xcd_barrier(xbar);

    KP_RELOAD;
    if constexpr (PHASES & 1024) {
        const int lane = my_lane();
        f32x4 gfin[4];
#pragma unroll
        for (int j = 0; j < 4; ++j) gfin[j] = *(const f32x4*)(kp->g_fin + 4 * lane + 256 * j);
        for (int m0 = gw; m0 < MT; m0 += 4 * NGW) {
            u32x2 v[4][4]; float rq[4];
#pragma unroll
            for (int u = 0; u < 4; ++u) { const int m = m0 + u * NGW < MT ? m0 + u * NGW : m0; rq[u] = rsq3[m];
#pragma unroll
                for (int j = 0; j < 4; ++j) v[u][j] = *(const u32x2*)(X3B + (size_t)m * 1024 + 4 * lane + 256 * j); }
#pragma unroll
            for (int u = 0; u < 4; ++u) { const int m = m0 + u * NGW < MT ? m0 + u * NGW : m0; if (u > 0 && m == m0) continue; const float rstd = __builtin_amdgcn_rsqf(rq[u] * (1.0f / 1024.0f) + EPSN);
#pragma unroll
                for (int j = 0; j < 4; ++j) { const f32x4 x = (f32x4){bflo(v[u][j].x), bfhi(v[u][j].x), bflo(v[u][j].y), bfhi(v[u][j].y)};
                    *(f32x4*)(kp->out + (size_t)m * 1024 + 4 * lane + 256 * j) = x * rstd * gfin[j]; } }
        }
    }
}

#undef Wt_in
#undef Wt_vna
#undef Wt_uq
#undef Wt_uk
#undef Wt_uv
#undef Wt_nao
#undef Wt_mlao
#undef Wt_out
#undef Wt_gu
#undef Wt_dn
#undef Wt_pg
#undef Wt_pl
#undef ropetab
#undef rsq1
#undef krope
#undef PB
#undef XN
#undef QNA
#undef KNA
#undef VTNA
#undef ZLAT
#undef ZQN
#undef ZKVN
#undef QM
#undef KN
#undef VTM
#undef MLAO
#undef T1
#undef U
#undef XB1
#undef HB
#undef XB2
#undef PW
#undef X3B
#undef rsqQ
#undef rsqKV
#undef rsq2
#undef rsq3
#undef NAO
#undef GATES

extern "C" void kernel_launch(void* const* d_in, const int* in_sizes, int n_in, void* d_out, int out_size, void* d_ws, size_t ws_size, hipStream_t stream) {
    static int grid_blocks = 0;
    if (grid_blocks == 0) {
        if (n_in != 21 || out_size != MT * DM || ws_size < WS_NEED) { fprintf(stderr, "kernel_launch: unexpected shapes (n_in %d out %d ws %zu)\n", n_in, out_size, ws_size); grid_blocks = -1; return; }
        int dev = 0, cus = 0, per_cu = 0;
        hipGetDevice(&dev);
        hipDeviceGetAttribute(&cus, hipDeviceAttributeMultiprocessorCount, dev);
        hipFuncSetAttribute((const void*)fwd_kernel, hipFuncAttributeMaxDynamicSharedMemorySize, LDS_BYTES);
        hipOccupancyMaxActiveBlocksPerMultiprocessor(&per_cu, (const void*)fwd_kernel, 512, LDS_BYTES);
        if (per_cu < 1) per_cu = 1;
        grid_blocks = cus * 1;
        (void)hipGetLastError();
    }
    if (grid_blocks < 0) return;
    if (hipMemsetAsync((unsigned char*)d_ws + WS_CTL, 0, CTL_BYTES, stream) != hipSuccess) { fprintf(stderr, "kernel_launch: memset failed\n"); return; }
    Params P{};
    const float** pp = (const float**)&P;
    for (int i = 0; i < 21; ++i) pp[i] = (const float*)d_in[i];
    P.out = (float*)d_out; P.ws = (unsigned char*)d_ws;
    void* args[] = {&P};
    hipError_t e = hipLaunchCooperativeKernel((const void*)fwd_kernel, dim3(grid_blocks), dim3(512), args, LDS_BYTES, stream);
    if (e != hipSuccess) fprintf(stderr, "cooperative launch failed: %s (grid %d)\n", hipGetErrorString(e), grid_blocks);
}
```

```cpp
#include <hip/hip_runtime.h>
#include <hip/hip_cooperative_groups.h>
#include <cstdio>
#include <cstdint>
namespace cg = cooperative_groups;
namespace pg8 {
#define PG8_LAS __attribute__((address_space(3)))
typedef unsigned short bf16_t;
typedef short bf16x8 __attribute__((ext_vector_type(8)));
typedef float f32x4 __attribute__((ext_vector_type(4)));
typedef unsigned u32x4 __attribute__((ext_vector_type(4)));
constexpr int BM = 256, BK = 64, HALF = 128, HTB = HALF * BK * 2  , STAGE_BYTES = 8 * HTB, NXCD = 8, WGM = 8;

__host__ __device__ __forceinline__ int lds_byte(int r, int c) { const int st = (r >> 4) * 2 + (c >> 5), rr = r & 15, cc = c & 31, ob = rr * 64 + cc * 2; return st * 1024 + (ob ^ (((ob >> 9) & 1) << 5)); }
__host__ __device__ __forceinline__ void stage_rc(int b, int& R, int& C) { const int st = b / 1024, sb = b % 1024, swz = sb ^ (((sb >> 9) & 1) << 5); R = (st >> 1) * 16 + swz / 64; C = (st & 1) * 32 + (swz % 64) / 2; }
__host__ __device__ __forceinline__ int perm32(int rho) { const int n = rho >> 4, i = rho & 15; return 8 * (i >> 2) + 4 * n + (i & 3); }

struct Unit { int pm, pn; int sel; };
struct Gemm { const bf16_t* A; const bf16_t* Bt; int M, N, K; int lda = 0, ldb = 0; const bf16_t* A2 = nullptr; const bf16_t* Bt2 = nullptr; };

struct StaticOrder {
    int nM, nN, nwg, G, c;
    __host__ __device__ void init(int M, int N, int G_, int c_) { nM = M / BM; nN = N / BM; nwg = nM * nN; G = G_; c = c_; }
    __host__ __device__ bool next(int i, Unit& u) const {
        const long L = (long)i * G + c; if (L >= nwg) return false;
        int wgid = (int)L; { const int q = nwg / NXCD, r = nwg % NXCD, xcd = wgid % NXCD, off = wgid / NXCD; wgid = (xcd < r ? xcd * (q + 1) : r * (q + 1) + (xcd - r) * q) + off; }
        const int nig = WGM * nN, gid = wgid / nig, fm = gid * WGM, gsz = (nM - fm) < WGM ? (nM - fm) : WGM;
        u.pm = fm + ((wgid % nig) % gsz); u.pn = (wgid % nig) / gsz; u.sel = 0; return true;
    }
    __device__ __forceinline__ void a_ready(const Unit&) const {}
    __device__ __forceinline__ void done(const Unit&) const {}
};

struct DualOrder {
    StaticOrder b;
    __host__ __device__ bool next(int i, Unit& u) const { const bool ok = b.next(i >> 1, u); u.sel = i & 1; return ok; }
    __device__ __forceinline__ void a_ready(const Unit&) const {}
    __device__ __forceinline__ void done(const Unit&) const {}
};
__device__ __forceinline__ unsigned cvt_pk_bf16(float lo, float hi) { unsigned r; asm volatile("v_cvt_pk_bf16_f32 %0, %1, %2" : "=v"(r) : "v"(lo), "v"(hi)); return r; }
typedef float f32x2 __attribute__((ext_vector_type(2)));
template <class Epi, class Sched, bool ALIGN_EPI = false, bool SP2 = false>
__device__ __forceinline__ void gemm_phase(PG8_LAS unsigned char* lds, const Gemm g, const Sched& S, const Epi& E, int tid_in) {
    int tid_ = tid_in; asm volatile("" : "+v"(tid_));
    const int tid = tid_, wid = __builtin_amdgcn_readfirstlane(tid >> 6), lane = tid & 63, wr = wid >> 2, wc = wid & 3, fr = lane & 15, fq = lane >> 4;
    const int K = g.K, nt = K / BK, lda = g.lda ? g.lda : K, ldb = g.ldb ? g.ldb : K;
    unsigned voffA[2], voffB[2];
#pragma unroll
    for (int i = 0; i < 2; ++i) { int R, C; stage_rc(tid * 16 + i * 8192, R, C); const int Rb = Epi::PERM ? ((R & ~31) + perm32(R & 31)) : R;
        voffA[i] = (unsigned)(R * lda + C) * 2u; voffB[i] = (unsigned)(Rb * ldb + C) * 2u; }
    const size_t kstep = (size_t)(BK * 2);
    const size_t hstepA = (size_t)HALF * lda * 2, hstepB = (size_t)HALF * ldb * 2;
    const size_t tstepA = 2 * hstepA, tstepB = 2 * hstepB;
    const unsigned ldsw = (unsigned)wid * 1024u;
    const int aoff = lds_byte(wr * 64 + fr, fq * 8), boff = lds_byte(wc * 32 + fr, fq * 8);
#define PG8_SA(b, h) (((b) * 2 + (h)) * HTB)
#define PG8_SB(b, h) ((4 + (b) * 2 + (h)) * HTB)
#define PG8_STAGE(bufoff, gbase, voff) do { _Pragma("unroll") for (int _i = 0; _i < 2; ++_i) \
        __builtin_amdgcn_global_load_lds((const unsigned*)((const char*)(gbase) + (voff)[_i]), (PG8_LAS unsigned*)(lds + (bufoff) + ldsw + _i * 8192), 16, 0, 0); } while (0)
#define PG8_LDA(dst, b, h) do { _Pragma("unroll") for (int m = 0; m < 4; ++m) _Pragma("unroll") for (int k = 0; k < 2; ++k) dst[m][k] = *(const PG8_LAS bf16x8*)(lds + PG8_SA(b, h) + aoff + m * 2048 + k * 1024); } while (0)
#define PG8_LDB(dst, b, h) do { _Pragma("unroll") for (int n = 0; n < 2; ++n) _Pragma("unroll") for (int k = 0; k < 2; ++k) dst[n][k] = *(const PG8_LAS bf16x8*)(lds + PG8_SB(b, h) + boff + n * 2048 + k * 1024); } while (0)
#define PG8_MMA(ai, bj, At, Bt) do { __builtin_amdgcn_s_setprio(1); _Pragma("unroll") for (int m = 0; m < 4; ++m) _Pragma("unroll") for (int n = 0; n < 2; ++n) _Pragma("unroll") for (int k = 0; k < 2; ++k) \
        acc[ai][bj][m][n] = __builtin_amdgcn_mfma_f32_16x16x32_bf16(Bt[n][k], At[m][k], acc[ai][bj][m][n], 0, 0, 0); __builtin_amdgcn_s_setprio(0); } while (0)
#define PG8_WAIT_V(n) asm volatile("s_waitcnt vmcnt(" #n ")" ::: "memory")
#define PG8_WAIT_L(n) asm volatile("s_waitcnt lgkmcnt(" #n ")" ::: "memory")
#define PG8_BAR __builtin_amdgcn_s_barrier()
#define PG8_SCHED __builtin_amdgcn_sched_barrier(0)
    Unit cur, nxt; int ui = 0;
    if (!S.next(0, cur)) return;
    f32x4 acc[2][2][4][2];
#pragma unroll
    for (int a = 0; a < 2; ++a)
#pragma unroll
        for (int b = 0; b < 2; ++b)
#pragma unroll
            for (int m = 0; m < 4; ++m)
#pragma unroll
                for (int n = 0; n < 2; ++n) acc[a][b][m][n] = (f32x4){0.f, 0.f, 0.f, 0.f};
    bf16x8 At[4][2], B0[2][2], B1[2][2];
    const char* cA = (const char*)(cur.sel ? g.A2 : g.A) + (size_t)cur.pm * tstepA; const char* cB = (const char*)(cur.sel ? g.Bt2 : g.Bt) + (size_t)cur.pn * tstepB;
    S.a_ready(cur);
    if constexpr (SP2) {
        PG8_STAGE(PG8_SB(0, 0), cB, voffB); PG8_STAGE(PG8_SB(0, 1), cB + hstepB, voffB); PG8_STAGE(PG8_SA(0, 0), cA, voffA); PG8_STAGE(PG8_SA(0, 1), cA + hstepA, voffA);
        if (wr == 1) PG8_BAR;
        PG8_WAIT_V(2); PG8_BAR;
        PG8_STAGE(PG8_SB(1, 0), cB + kstep, voffB); PG8_STAGE(PG8_SA(1, 0), cA + kstep, voffA); PG8_STAGE(PG8_SB(1, 1), cB + hstepB + kstep, voffB);
        PG8_WAIT_V(6); PG8_BAR;
    } else {
        PG8_STAGE(PG8_SB(0, 0), cB, voffB); PG8_STAGE(PG8_SA(0, 0), cA, voffA); PG8_STAGE(PG8_SB(0, 1), cB + hstepB, voffB); PG8_STAGE(PG8_SA(0, 1), cA + hstepA, voffA);
        if (wr == 1) PG8_BAR;
        PG8_WAIT_V(4); PG8_BAR;
        PG8_STAGE(PG8_SB(1, 0), cB + kstep, voffB); PG8_STAGE(PG8_SA(1, 0), cA + kstep, voffA); PG8_STAGE(PG8_SB(1, 1), cB + hstepB + kstep, voffB);
        PG8_WAIT_V(6); PG8_BAR;
    }
    for (;;) {
        const bool has_next = S.next(ui + 1, nxt);
        const char* nA = has_next ? (const char*)(nxt.sel ? g.A2 : g.A) + (size_t)nxt.pm * tstepA : cA; const char* nB = has_next ? (const char*)(nxt.sel ? g.Bt2 : g.Bt) + (size_t)nxt.pn * tstepB : cB;
        for (int t = 0; t < nt; t += 2) {
            const bool last = (t == nt - 2);
            const char* a1 = cA + (size_t)(t + 1) * kstep;
            const char* a2 = last ? nA : cA + (size_t)(t + 2) * kstep; const char* b2 = last ? nB : cB + (size_t)(t + 2) * kstep;
            const char* a3 = a2 + kstep; const char* b3 = b2 + kstep;
            if (last && has_next) S.a_ready(nxt);
            if constexpr (SP2) {
            PG8_LDB(B0, 0, 0); PG8_LDB(B1, 0, 1); PG8_SCHED; PG8_LDA(At, 0, 0); PG8_STAGE(PG8_SA(1, 1), a1 + hstepA, voffA);
            PG8_WAIT_V(8); PG8_WAIT_L(0); PG8_BAR; PG8_MMA(0, 0, At, B0); PG8_MMA(0, 1, At, B1); PG8_BAR; PG8_SCHED;
            PG8_LDA(At, 0, 1); PG8_STAGE(PG8_SB(0, 0), b2, voffB); PG8_STAGE(PG8_SB(0, 1), b2 + hstepB, voffB); PG8_STAGE(PG8_SA(0, 0), a2, voffA);
            PG8_WAIT_V(8); PG8_WAIT_L(0); PG8_BAR; PG8_MMA(1, 0, At, B0); PG8_MMA(1, 1, At, B1); PG8_BAR; PG8_SCHED;
            PG8_LDB(B0, 1, 0); PG8_LDB(B1, 1, 1); PG8_SCHED; PG8_LDA(At, 1, 0); PG8_STAGE(PG8_SA(0, 1), a2 + hstepA, voffA);
            PG8_WAIT_V(8); PG8_WAIT_L(0); PG8_BAR; PG8_MMA(0, 0, At, B0); PG8_MMA(0, 1, At, B1); PG8_BAR; PG8_SCHED;
            PG8_LDA(At, 1, 1); PG8_STAGE(PG8_SB(1, 0), b3, voffB); PG8_STAGE(PG8_SB(1, 1), b3 + hstepB, voffB); PG8_STAGE(PG8_SA(1, 0), a3, voffA);
            PG8_WAIT_V(8); PG8_WAIT_L(0); PG8_BAR; PG8_MMA(1, 0, At, B0); PG8_MMA(1, 1, At, B1); PG8_BAR; PG8_SCHED;
            } else {
            PG8_LDB(B0, 0, 0); PG8_SCHED; PG8_LDA(At, 0, 0); PG8_STAGE(PG8_SA(1, 1), a1 + hstepA, voffA);
            PG8_WAIT_L(8); PG8_BAR; PG8_WAIT_L(0); PG8_MMA(0, 0, At, B0); PG8_BAR; PG8_SCHED;
            PG8_LDB(B1, 0, 1); PG8_STAGE(PG8_SB(0, 0), b2, voffB);
            PG8_BAR; PG8_WAIT_L(0); PG8_MMA(0, 1, At, B1); PG8_BAR;
            PG8_LDA(At, 0, 1); PG8_STAGE(PG8_SA(0, 0), a2, voffA);
            PG8_BAR; PG8_WAIT_L(0); PG8_MMA(1, 0, At, B0); PG8_BAR; PG8_SCHED;
            PG8_STAGE(PG8_SB(0, 1), b2 + hstepB, voffB);
            PG8_WAIT_V(6); PG8_BAR; PG8_MMA(1, 1, At, B1); PG8_BAR;
            PG8_LDB(B0, 1, 0); PG8_SCHED; PG8_LDA(At, 1, 0); PG8_STAGE(PG8_SA(0, 1), a2 + hstepA, voffA);
            PG8_WAIT_L(8); PG8_BAR; PG8_WAIT_L(0); PG8_MMA(0, 0, At, B0); PG8_BAR; PG8_SCHED;
            PG8_LDB(B1, 1, 1); PG8_STAGE(PG8_SB(1, 0), b3, voffB);
            PG8_BAR; PG8_WAIT_L(0); PG8_MMA(0, 1, At, B1); PG8_BAR;
            PG8_LDA(At, 1, 1); PG8_STAGE(PG8_SA(1, 0), a3, voffA);
            PG8_BAR; PG8_WAIT_L(0); PG8_MMA(1, 0, At, B0); PG8_BAR; PG8_SCHED;
            PG8_STAGE(PG8_SB(1, 1), b3 + hstepB, voffB);
            PG8_WAIT_V(6); PG8_BAR; PG8_MMA(1, 1, At, B1); PG8_BAR;
            }
        }
        if constexpr (ALIGN_EPI) { if (wr == 0) PG8_BAR; }
        if constexpr (!Epi::AFTER_DRAIN) { E(acc, cur, wr, wc, fr, fq); S.done(cur); }
        if (!has_next) break;
        if (!Epi::DUAL || cur.sel == 1) {
#pragma unroll
        for (int a = 0; a < 2; ++a)
#pragma unroll
            for (int b = 0; b < 2; ++b)
#pragma unroll
                for (int m = 0; m < 4; ++m)
#pragma unroll
                    for (int n = 0; n < 2; ++n) acc[a][b][m][n] = (f32x4){0.f, 0.f, 0.f, 0.f};
        }
        cur = nxt; cA = nA; cB = nB; ++ui;
        if constexpr (ALIGN_EPI) { if (wr == 1) PG8_BAR; }
    }
    PG8_WAIT_V(0);
    if constexpr (!ALIGN_EPI) { if (wr == 0) PG8_BAR; }
    PG8_BAR;
    if constexpr (Epi::AFTER_DRAIN) { E.fused(acc, cur, wr, wc, fr, fq, lds, wid, lane); S.done(cur); }
#undef PG8_SA
#undef PG8_SB
#undef PG8_STAGE
#undef PG8_LDA
#undef PG8_LDB
#undef PG8_MMA
#undef PG8_WAIT_V
#undef PG8_WAIT_L
#undef PG8_BAR
#undef PG8_SCHED
}
}

#define LAS __attribute__((address_space(3)))
typedef unsigned short bf16_t;
typedef short bf16x8 __attribute__((ext_vector_type(8)));
typedef short s16x4 __attribute__((ext_vector_type(4)));
typedef float f32x4 __attribute__((ext_vector_type(4)));
typedef float f32x16 __attribute__((ext_vector_type(16)));
typedef unsigned u32x4 __attribute__((ext_vector_type(4)));
typedef unsigned u32x2 __attribute__((ext_vector_type(2)));

constexpr int DM = 1024, MP = 65536, MS_ = 32768, MT = 98304, SP = 8192, SS = 16384, DFF = 2816;
constexpr int NIN = 3840;
constexpr float EPSN = 1e-6f;
constexpr float LOG2E = 1.4426950408889634f;
constexpr float QS_NA = 0.125f * LOG2E;
constexpr float QS_M = 0.10206207261596575f * LOG2E;

constexpr size_t MiB = 1u << 20;
constexpr size_t W_IN = 0, W_VNA = W_IN + (size_t)NIN * 1024 * 2, W_UQ = W_VNA + 512 * 1024 * 2, W_UK = W_UQ + 768 * 384 * 2, W_UV = W_UK + 512 * 256 * 2,
                 W_NAO = W_UV + 512 * 256 * 2, W_MLAO = W_NAO + 1024 * 512 * 2, W_OUT = W_MLAO + 1024 * 512 * 2, W_GU = W_OUT + 1024 * 1024 * 2,
                 W_DN = W_GU + (size_t)5632 * 1024 * 2, W_PG = W_DN + (size_t)1024 * 2816 * 2, W_PL = W_PG + 1024 * 1024 * 2, W_END = W_PL + 1024 * 256 * 2;
static_assert(W_END <= 34 * MiB, "weights region");
constexpr size_t WS_CTL = 33 * MiB, CTL_BYTES = 16384;
static_assert(W_END <= WS_CTL, "ctl after weights");
constexpr size_t WS_ROPE = 34 * MiB;
constexpr size_t WS_RSQ = 36 * MiB;
constexpr size_t WS_KROPE = 38 * MiB;
constexpr size_t WS_PB = 44 * MiB;
constexpr size_t WS_XN = 92 * MiB;
constexpr size_t WS_QNA = 284 * MiB, WS_KNA = 380 * MiB, WS_VTNA = 476 * MiB;
constexpr size_t WS_ZLAT = 572 * MiB;
constexpr size_t WS_ZQN = 716 * MiB, WS_ZKVN = 788 * MiB;
constexpr size_t WS_QM = 92 * MiB;
constexpr size_t WS_KN = 716 * MiB;
constexpr size_t WS_VTM = 836 * MiB;
constexpr size_t WS_MLAO = 572 * MiB;
constexpr size_t WS_T1 = 92 * MiB;
constexpr size_t WS_U = 380 * MiB;
constexpr size_t WS_XB1 = 92 * MiB;
constexpr size_t WS_H = 284 * MiB;
constexpr size_t WS_XB2 = 92 * MiB;
constexpr size_t WS_PW = 284 * MiB;
constexpr size_t WS_NEED = 932 * MiB;

#ifndef PHASES
#define PHASES 0x7ff
#endif
constexpr int LDS_BYTES = 147456;

struct Params {
    const float *x_p, *x_s, *p_p, *p_s, *g_mix, *w_in, *rpb, *g_q, *w_uq, *g_kv, *w_ukv, *w_nao, *w_mlao, *w_out, *g_ffn, *w_gu, *w_dn, *g_ple, *w_pg, *w_pl, *g_fin;
    float* out; unsigned char* ws;
};

__device__ __forceinline__ unsigned pk2(float lo, float hi) { return pg8::cvt_pk_bf16(lo, hi); }
__device__ __forceinline__ float bf2f(unsigned short b) { return __uint_as_float((unsigned)b << 16); }
__device__ __forceinline__ float bflo(unsigned w) { return __uint_as_float(w << 16); }
__device__ __forceinline__ float bfhi(unsigned w) { return __uint_as_float(w & 0xffff0000u); }
__device__ __forceinline__ float sigmoidf_(float x) { return __builtin_amdgcn_rcpf(1.0f + __builtin_amdgcn_exp2f(-x * LOG2E)); }
__device__ __forceinline__ void store8(bf16_t* p, f32x4 a, f32x4 b) { u32x4 w; w.x = pk2(a[0], a[1]); w.y = pk2(a[2], a[3]); w.z = pk2(b[0], b[1]); w.w = pk2(b[2], b[3]); *(u32x4*)p = w; }
__device__ __forceinline__ float wave_sum(float v) {
#pragma unroll
    for (int o = 1; o < 64; o <<= 1) v += __shfl_xor(v, o);
    return v;
}
__device__ __forceinline__ int opq(int v) { asm volatile("" : "+s"(v)); return v; }
__device__ __forceinline__ int my_lane() { int l; asm volatile("v_mbcnt_lo_u32_b32 %0, -1, 0\n\tv_mbcnt_hi_u32_b32 %0, -1, %0" : "=v"(l)); return l; }
__device__ __forceinline__ int row_pos(int row) { return row < MP ? (row & (SP - 1)) : (row & (SS - 1)); }

typedef f32x4 Acc[2][2][4][2];
#define EPI_ROWS(ai, m) (u.pm * 256 + (ai) * 128 + wr * 64 + (m) * 16 + fr)
#define EPI_COL(bj) (u.pn * 256 + (bj) * 128 + wc * 32 + 8 * fq)

__device__ __forceinline__ void rowsum_atomic4(float* dst, const float (&ss)[4], int row0  , int fq) {
    const float v = fq == 0 ? ss[0] : fq == 1 ? ss[1] : fq == 2 ? ss[2] : ss[3];
    unsafeAtomicAdd(dst + row0 + 16 * fq, v);
}
struct EpiIn {
    static constexpr bool PERM = true, AFTER_DRAIN = false, DUAL = false;
    bf16_t *qna, *kna, *gates, *zlat; float *rsq_q, *rsq_kv;
    __device__ __forceinline__ void operator()(const Acc& acc, const pg8::Unit& u, int wr, int wc, int fr, int fq) const {
        const int pn = u.pn; bf16_t* base; int ldc, cb, mode;
        if (pn < 2) { base = qna; ldc = 512; cb = pn * 256; mode = 1; }
        else if (pn < 4) { base = kna; ldc = 512; cb = (pn - 2) * 256; mode = 0; }
        else if (pn < 12) { base = gates; ldc = 2048; cb = (pn - 4) * 256; mode = 2; }
        else { base = zlat; ldc = 768; cb = (pn - 12) * 256; mode = 0; }
        const float sc = mode == 1 ? QS_NA : 1.0f;
#pragma unroll
        for (int ai = 0; ai < 2; ++ai) { float sq[4] = {0.f, 0.f, 0.f, 0.f}, sk[4] = {0.f, 0.f, 0.f, 0.f};
#pragma unroll
            for (int m = 0; m < 4; ++m) {
                bf16_t* rowp = base + (size_t)EPI_ROWS(ai, m) * ldc + cb + wc * 32 + 8 * fq;
#pragma unroll
                for (int bj = 0; bj < 2; ++bj) {
                    f32x4 v0 = acc[ai][bj][m][0], v1 = acc[ai][bj][m][1];
                    if (mode == 2) {
#pragma unroll
                        for (int e = 0; e < 4; ++e) { v0[e] = sigmoidf_(v0[e]); v1[e] = sigmoidf_(v1[e]); }
                    } else { v0 = v0 * sc; v1 = v1 * sc; }
                    store8(rowp + bj * 128, v0, v1);
                    if (pn >= 12) {
                        const bool isq = (pn == 12 || (pn == 13 && bj == 0)), iskv = !isq && (pn == 13 || bj == 0);
                        if (isq || iskv) { float ss = (v0[0] * v0[0] + v0[1] * v0[1]) + (v0[2] * v0[2] + v0[3] * v0[3]) + (v1[0] * v1[0] + v1[1] * v1[1]) + (v1[2] * v1[2] + v1[3] * v1[3]);
                            ss += __shfl_xor(ss, 16); ss += __shfl_xor(ss, 32);
                            if (isq) sq[m] += ss; else sk[m] += ss; }
                    }
                }
            }
            if (pn >= 12) { if (pn <= 13) rowsum_atomic4(rsq_q, sq, EPI_ROWS(ai, 0), fq); if (pn >= 13) rowsum_atomic4(rsq_kv, sk, EPI_ROWS(ai, 0), fq); }
        }
    }
};
struct EpiPlain {
    static constexpr bool PERM = true, AFTER_DRAIN = false, DUAL = false;
    bf16_t* O; int ldc;
    __device__ __forceinline__ void operator()(const Acc& acc, const pg8::Unit& u, int wr, int wc, int fr, int fq) const {
#pragma unroll
        for (int ai = 0; ai < 2; ++ai)
#pragma unroll
            for (int m = 0; m < 4; ++m) {
                bf16_t* rowp = O + (size_t)EPI_ROWS(ai, m) * ldc + EPI_COL(0);
#pragma unroll
                for (int bj = 0; bj < 2; ++bj) store8(rowp + bj * 128, acc[ai][bj][m][0], acc[ai][bj][m][1]);
            }
    }
};
struct EpiPlainPermT {
    static constexpr bool PERM = true, AFTER_DRAIN = false, DUAL = false;
    bf16_t* O; int ldc;
    __device__ __forceinline__ void operator()(const Acc& acc, const pg8::Unit& u, int wr, int wc, int fr, int fq) const {
#pragma unroll
        for (int bj = 0; bj < 2; ++bj) { const int col = EPI_COL(bj);
#pragma unroll
            for (int ai = 0; ai < 2; ++ai)
#pragma unroll
                for (int m = 0; m < 4; ++m) { const f32x4 v0 = acc[ai][bj][m][0], v1 = acc[ai][bj][m][1];
                    bf16_t* p = O + (size_t)EPI_ROWS(ai, m) * ldc + (col & ~15) + ((col & 8) ? 4 : 0);
                    u32x2 w0, w1; w0.x = pk2(v0[0], v0[1]); w0.y = pk2(v0[2], v0[3]); w1.x = pk2(v1[0], v1[1]); w1.y = pk2(v1[2], v1[3]);
                    *(u32x2*)p = w0; *(u32x2*)(p + 8) = w1; } }
    }
};
struct EpiRowScale {
    static constexpr bool PERM = true, AFTER_DRAIN = false, DUAL = false;
    bf16_t* O; int ldc; const float* rsq; float invn;
    __device__ __forceinline__ void operator()(const Acc& acc, const pg8::Unit& u, int wr, int wc, int fr, int fq) const {
        float rq[2][4];
#pragma unroll
        for (int ai = 0; ai < 2; ++ai)
#pragma unroll
            for (int m = 0; m < 4; ++m) rq[ai][m] = rsq[EPI_ROWS(ai, m)];
#pragma unroll
        for (int ai = 0; ai < 2; ++ai)
#pragma unroll
            for (int m = 0; m < 4; ++m) {
                const float rstd = __builtin_amdgcn_rsqf(rq[ai][m] * invn + EPSN);
                bf16_t* rowp = O + (size_t)EPI_ROWS(ai, m) * ldc + EPI_COL(0);
#pragma unroll
                for (int bj = 0; bj < 2; ++bj) store8(rowp + bj * 128, acc[ai][bj][m][0] * rstd, acc[ai][bj][m][1] * rstd);
            }
    }
};
struct EpiColScale {
    static constexpr bool PERM = true, AFTER_DRAIN = false, DUAL = false;
    bf16_t* O; int ldc; const float* rsq; float invn;
    __device__ __forceinline__ void operator()(const Acc& acc, const pg8::Unit& u, int wr, int wc, int fr, int fq) const {
#pragma unroll
        for (int bj = 0; bj < 2; ++bj) {
            const int col = EPI_COL(bj);
            f32x4 r0 = *(const f32x4*)(rsq + col), r1 = *(const f32x4*)(rsq + col + 4);
#pragma unroll
            for (int e = 0; e < 4; ++e) { r0[e] = __builtin_amdgcn_rsqf(r0[e] * invn + EPSN); r1[e] = __builtin_amdgcn_rsqf(r1[e] * invn + EPSN); }
#pragma unroll
            for (int ai = 0; ai < 2; ++ai)
#pragma unroll
                for (int m = 0; m < 4; ++m) {
                    const f32x4 v0 = acc[ai][bj][m][0] * r0, v1 = acc[ai][bj][m][1] * r1;
                    bf16_t* p = O + (size_t)EPI_ROWS(ai, m) * ldc + (col & ~15) + ((col & 8) ? 4 : 0);
                    u32x2 w0, w1; w0.x = pk2(v0[0], v0[1]); w0.y = pk2(v0[2], v0[3]); w1.x = pk2(v1[0], v1[1]); w1.y = pk2(v1[2], v1[3]);
                    *(u32x2*)p = w0; *(u32x2*)(p + 8) = w1; }
        }
    }
};
struct EpiQRope {
    static constexpr bool PERM = true, AFTER_DRAIN = false, DUAL = false;
    bf16_t* Qm; const float2* tab; const float* rsq;
    __device__ __forceinline__ void operator()(const Acc& acc, const pg8::Unit& u, int wr, int wc, int fr, int fq) const {
        const bool rope0 = ((u.pn * 8 + wc) % 3) == 2, rope1 = ((u.pn * 8 + 4 + wc) % 3) == 2, anyrope = rope0 || rope1;
#pragma unroll
        for (int ai = 0; ai < 2; ++ai) {
            f32x4 cs[4][2]; float rq[4];
#pragma unroll
            for (int m = 0; m < 4; ++m) rq[m] = rsq[EPI_ROWS(ai, m)];
            if (anyrope) {
#pragma unroll
                for (int m = 0; m < 4; ++m) { const f32x4* t = (const f32x4*)(tab + (size_t)row_pos(EPI_ROWS(ai, m)) * 16 + 4 * fq); cs[m][0] = t[0]; cs[m][1] = t[1]; }
            }
#pragma unroll
            for (int m = 0; m < 4; ++m) {
                const int row = EPI_ROWS(ai, m);
#pragma unroll
                for (int bj = 0; bj < 2; ++bj) {
                    const float sc = QS_M * __builtin_amdgcn_rsqf(rq[m] * (1.0f / 384.0f) + EPSN);
                    f32x4 v0 = acc[ai][bj][m][0] * sc, v1 = acc[ai][bj][m][1] * sc;
                    if (bj == 0 ? rope0 : rope1) {
#pragma unroll
                        for (int e = 0; e < 4; ++e) { const float cc = cs[m][e >> 1][2 * (e & 1)], sn = cs[m][e >> 1][2 * (e & 1) + 1]; const float a = v0[e], b = v1[e]; v0[e] = a * cc - b * sn; v1[e] = b * cc + a * sn; }
                    }
                    store8(Qm + (size_t)row * 768 + EPI_COL(bj), v0, v1);
                }
            }
            asm volatile("" ::: "memory");
        }
    }
};
struct EpiGateDual {
    static constexpr bool PERM = true, AFTER_DRAIN = false, DUAL = true;
    bf16_t* U; const bf16_t* gates;
    __device__ __forceinline__ void operator()(Acc& acc, const pg8::Unit& u, int wr, int wc, int fr, int fq) const {
        if (u.sel == 0) {
#pragma unroll
            for (int ai = 0; ai < 2; ++ai)
#pragma unroll
                for (int mp = 0; mp < 2; ++mp) {
                    u32x4 ga[2][2], gb[2][2];
#pragma unroll
                    for (int mm = 0; mm < 2; ++mm)
#pragma unroll
                        for (int bj = 0; bj < 2; ++bj) { const bf16_t* gp = gates + (size_t)EPI_ROWS(ai, 2 * mp + mm) * 2048 + EPI_COL(bj); ga[mm][bj] = *(const u32x4*)gp; gb[mm][bj] = *(const u32x4*)(gp + 1024); }
#pragma unroll
                    for (int mm = 0; mm < 2; ++mm)
#pragma unroll
                        for (int bj = 0; bj < 2; ++bj) { const int m = 2 * mp + mm; const u32x4 a = ga[mm][bj], b = gb[mm][bj];
#define RATIO_(x, y) ((x) * __builtin_amdgcn_rcpf(fmaxf((y), 1e-30f)))
                            acc[ai][bj][m][0][0] *= RATIO_(bflo(a.x), bflo(b.x)); acc[ai][bj][m][0][1] *= RATIO_(bfhi(a.x), bfhi(b.x)); acc[ai][bj][m][0][2] *= RATIO_(bflo(a.y), bflo(b.y)); acc[ai][bj][m][0][3] *= RATIO_(bfhi(a.y), bfhi(b.y));
                            acc[ai][bj][m][1][0] *= RATIO_(bflo(a.z), bflo(b.z)); acc[ai][bj][m][1][1] *= RATIO_(bfhi(a.z), bfhi(b.z)); acc[ai][bj][m][1][2] *= RATIO_(bflo(a.w), bflo(b.w)); acc[ai][bj][m][1][3] *= RATIO_(bfhi(a.w), bfhi(b.w));
#undef RATIO_
                        }
                    asm volatile("" ::: "memory");
                }
        } else {
#pragma unroll
            for (int ai = 0; ai < 2; ++ai) {
                u32x4 g[4][2];
#pragma unroll
                for (int m = 0; m < 4; ++m)
#pragma unroll
                    for (int bj = 0; bj < 2; ++bj) g[m][bj] = *(const u32x4*)(gates + (size_t)EPI_ROWS(ai, m) * 2048 + 1024 + EPI_COL(bj));
#pragma unroll
                for (int m = 0; m < 4; ++m)
#pragma unroll
                    for (int bj = 0; bj < 2; ++bj) { const u32x4 gg = g[m][bj];
                        f32x4 v0 = acc[ai][bj][m][0], v1 = acc[ai][bj][m][1];
                        v0[0] *= bflo(gg.x); v0[1] *= bfhi(gg.x); v0[2] *= bflo(gg.y); v0[3] *= bfhi(gg.y);
                        v1[0] *= bflo(gg.z); v1[1] *= bfhi(gg.z); v1[2] *= bflo(gg.w); v1[3] *= bfhi(gg.w);
                        store8(U + (size_t)EPI_ROWS(ai, m) * 1024 + EPI_COL(bj), v0, v1); }
                asm volatile("" ::: "memory");
            }
        }
    }
};
template <bool BASE_BF16> struct EpiResid {
    static constexpr bool PERM = true, AFTER_DRAIN = false, DUAL = false;
    const float* base_p; const float* base_s;
    const bf16_t* base_b; bf16_t* XB; float* rowsq;
    __device__ __forceinline__ void operator()(const Acc& acc, const pg8::Unit& u, int wr, int wc, int fr, int fq) const {
#pragma unroll
        for (int ai = 0; ai < 2; ++ai) { float ssv[4];
#pragma unroll
            for (int mp = 0; mp < 2; ++mp) {
                f32x4 b[2][2][2];
#pragma unroll
                for (int mm = 0; mm < 2; ++mm) { const int row = EPI_ROWS(ai, 2 * mp + mm);
                    if (BASE_BF16) {
#pragma unroll
                        for (int bj = 0; bj < 2; ++bj) { const u32x4 t = *(const u32x4*)(base_b + (size_t)row * 1024 + EPI_COL(bj));
                            b[mm][bj][0] = (f32x4){bflo(t.x), bfhi(t.x), bflo(t.y), bfhi(t.y)}; b[mm][bj][1] = (f32x4){bflo(t.z), bfhi(t.z), bflo(t.w), bfhi(t.w)}; }
                    } else {
                        const float* brow = row < MP ? base_p + (size_t)row * 1024 : base_s + (size_t)(row - MP) * 1024;
#pragma unroll
                        for (int bj = 0; bj < 2; ++bj) { b[mm][bj][0] = *(const f32x4*)(brow + EPI_COL(bj)); b[mm][bj][1] = *(const f32x4*)(brow + EPI_COL(bj) + 4); }
                    } }
#pragma unroll
                for (int mm = 0; mm < 2; ++mm) { const int m = 2 * mp + mm, row = EPI_ROWS(ai, m); float ss = 0.f;
#pragma unroll
                    for (int bj = 0; bj < 2; ++bj) { const int col = EPI_COL(bj);
                        const f32x4 v0 = acc[ai][bj][m][0] + b[mm][bj][0], v1 = acc[ai][bj][m][1] + b[mm][bj][1];
                        store8(XB + (size_t)row * 1024 + col, v0, v1);
                        ss += (v0[0] * v0[0] + v0[1] * v0[1]) + (v0[2] * v0[2] + v0[3] * v0[3]) + (v1[0] * v1[0] + v1[1] * v1[1]) + (v1[2] * v1[2] + v1[3] * v1[3]); }
                    ss += __shfl_xor(ss, 16); ss += __shfl_xor(ss, 32);
                    ssv[m] = ss; }
                asm volatile("" ::: "memory");
            }
            rowsum_atomic4(rowsq, ssv, EPI_ROWS(ai, 0), fq); }
    }
};
struct EpiGLU {
    static constexpr bool PERM = true, AFTER_DRAIN = false, DUAL = false;
    bf16_t* H; const float* rowsq;
    __device__ __forceinline__ void operator()(const Acc& acc, const pg8::Unit& u, int wr, int wc, int fr, int fq) const {
        float rq[2][4];
#pragma unroll
        for (int ai = 0; ai < 2; ++ai)
#pragma unroll
            for (int m = 0; m < 4; ++m) rq[ai][m] = rowsq[EPI_ROWS(ai, m)];
#pragma unroll
        for (int ai = 0; ai < 2; ++ai)
#pragma unroll
            for (int m = 0; m < 4; ++m) {
                const int row = EPI_ROWS(ai, m);
                const float rstd = __builtin_amdgcn_rsqf(rq[ai][m] * (1.0f / 1024.0f) + EPSN);
#pragma unroll
                for (int bj = 0; bj < 2; ++bj) {
                    const int hc = u.pn * 128 + bj * 64 + wc * 16 + 4 * fq;
                    const f32x4 g = acc[ai][bj][m][0] * rstd, up = acc[ai][bj][m][1] * rstd;
                    float h[4];
#pragma unroll
                    for (int e = 0; e < 4; ++e) h[e] = g[e] * sigmoidf_(g[e]) * up[e];
                    u32x2 w; w.x = pk2(h[0], h[1]); w.y = pk2(h[2], h[3]);
                    *(u32x2*)(H + (size_t)row * DFF + hc) = w;
                }
            }
    }
};
struct EpiPle {
    static constexpr bool PERM = true, AFTER_DRAIN = false, DUAL = false;
    const bf16_t* X2B; bf16_t* X3B; const bf16_t* PW; const float* rowsq2; float* rowsq3;
    __device__ __forceinline__ void operator()(const Acc& acc, const pg8::Unit& u, int wr, int wc, int fr, int fq) const {
        float rq[2][4];
#pragma unroll
        for (int ai = 0; ai < 2; ++ai)
#pragma unroll
            for (int m = 0; m < 4; ++m) rq[ai][m] = rowsq2[EPI_ROWS(ai, m)];
#pragma unroll
        for (int ai = 0; ai < 2; ++ai) { float ssv[4];
#pragma unroll
            for (int mp = 0; mp < 2; ++mp) {
                u32x4 xb[2][2], t[2][2];
#pragma unroll
                for (int mm = 0; mm < 2; ++mm)
#pragma unroll
                    for (int bj = 0; bj < 2; ++bj) { const size_t off = (size_t)EPI_ROWS(ai, 2 * mp + mm) * 1024 + EPI_COL(bj);
                        xb[mm][bj] = *(const u32x4*)(X2B + off); t[mm][bj] = *(const u32x4*)(PW + off); }
#pragma unroll
                for (int mm = 0; mm < 2; ++mm) { const int m = 2 * mp + mm, row = EPI_ROWS(ai, m);
                    const float rstd = __builtin_amdgcn_rsqf(rq[ai][m] * (1.0f / 1024.0f) + EPSN); float ss = 0.f;
#pragma unroll
                    for (int bj = 0; bj < 2; ++bj) {
                        const u32x4 bb = xb[mm][bj], tt = t[mm][bj];
                        const f32x4 a0 = acc[ai][bj][m][0] * rstd, a1 = acc[ai][bj][m][1] * rstd;
                        f32x4 v0, v1;
                        v0[0] = bflo(bb.x) + sigmoidf_(a0[0]) * bflo(tt.x); v0[1] = bfhi(bb.x) + sigmoidf_(a0[1]) * bfhi(tt.x); v0[2] = bflo(bb.y) + sigmoidf_(a0[2]) * bflo(tt.y); v0[3] = bfhi(bb.y) + sigmoidf_(a0[3]) * bfhi(tt.y);
                        v1[0] = bflo(bb.z) + sigmoidf_(a1[0]) * bflo(tt.z); v1[1] = bfhi(bb.z) + sigmoidf_(a1[1]) * bfhi(tt.z); v1[2] = bflo(bb.w) + sigmoidf_(a1[2]) * bflo(tt.w); v1[3] = bfhi(bb.w) + sigmoidf_(a1[3]) * bfhi(tt.w);
                        store8(X3B + (size_t)row * 1024 + EPI_COL(bj), v0, v1);
                        ss += (v0[0] * v0[0] + v0[1] * v0[1]) + (v0[2] * v0[2] + v0[3] * v0[3]) + (v1[0] * v1[0] + v1[1] * v1[1]) + (v1[2] * v1[2] + v1[3] * v1[3]); }
                    ss += __shfl_xor(ss, 16); ss += __shfl_xor(ss, 32);
                    ssv[m] = ss; }
                asm volatile("" ::: "memory");
            }
            rowsum_atomic4(rowsq3, ssv, EPI_ROWS(ai, 0), fq); }
    }
};

constexpr int A_K0 = 0, A_KB = 13312, A_V0 = 4 * A_KB, A_VB = 9216, A_TBL = A_V0 + 4 * A_VB + 1024;
static_assert(A_TBL + 465 * 4 < 131072, "attention LDS");

__device__ __forceinline__ float max3f(float a, float b, float c) { float r; asm("v_max3_f32 %0, %1, %2, %3" : "=v"(r) : "v"(a), "v"(b), "v"(c)); return r; }
__device__ __forceinline__ float rowmax32(const f32x16& p0, const f32x16& p1) {
    float a = max3f(p0[0], p0[1], p1[0]), b = max3f(p0[2], p0[3], p1[1]); a = max3f(a, p1[2], p1[3]);
#pragma unroll
    for (int r = 4; r < 16; r += 4) { a = max3f(a, p0[r], p0[r + 1]); b = max3f(b, p0[r + 2], p0[r + 3]); a = max3f(a, p1[r], p1[r + 1]); b = max3f(b, p1[r + 2], p1[r + 3]); }
    const float m = fmaxf(a, b);
    auto rr = __builtin_amdgcn_permlane32_swap(__float_as_uint(m), __float_as_uint(m), false, false);
    return fmaxf(__uint_as_float(rr[0]), __uint_as_float(rr[1]));
}
__device__ __forceinline__ void glds16(const void* gsrc, unsigned lds_dst) { unsigned keep;
    asm volatile("s_mov_b32 %0, m0\n\ts_mov_b32 m0, %2\n\ts_nop 0\n\tglobal_load_lds_dwordx4 %1, off\n\ts_mov_b32 m0, %0" : "=&s"(keep) : "v"(gsrc), "s"(lds_dst) : "memory"); }
template <int LO, int HI> __device__ __forceinline__ void g_exp(f32x16& X) {
#pragma unroll
    for (int r = LO; r < HI; ++r) X[r] = __builtin_amdgcn_exp2f(X[r]);
}
template <int LO, int HI> __device__ __forceinline__ void g_sumpk(const f32x16& X, float& psa, float& psb, u32x4& pwlo, u32x4& pwhi) {
#pragma unroll
    for (int r = LO; r < HI; r += 2) { psa += X[r]; psb += X[r + 1]; const unsigned w = pk2(X[r], X[r + 1]); if (r < 8) pwlo[(r >> 1) & 3] = w; else pwhi[(r >> 1) & 3] = w; }
    asm volatile("" : "+v"(psa), "+v"(psb));
}
constexpr float A_THR = 8.0f;

template <bool NA>
__device__ __forceinline__ void attn_unit(LAS unsigned char* lds, const bf16_t* Q, const bf16_t* Kg, const bf16_t* Kr, const bf16_t* Vt, bf16_t* O,
                                          int h, int seqrow0, int q0, int t0, int NT, int rows, int g0, const float* rpb_h, int wid) {
    constexpr int DQK = NA ? 64 : 96, NJ = DQK / 16, KP = DQK + 8, QPITCH = NA ? 512 : 768;
    const int lane = my_lane(), tid = wid * 64 + lane, r32 = lane & 31, hi = lane >> 5;
    const int kvr = tid >> 3, c8 = tid & 7;
    const bf16_t* ksrc = Kg + (size_t)(seqrow0 + t0 * 64 + kvr) * 512 + h * 64 + 8 * c8;
    const bf16_t* rsrc = NA ? nullptr : Kr + (size_t)(seqrow0 + t0 * 64 + (tid >> 2)) * 32 + 8 * (tid & 3);
    const bf16_t* vsrc = Vt + (size_t)(h * 64 + kvr) * MT + seqrow0 + t0 * 64 + 8 * c8;
    const unsigned kdst = A_K0 + (kvr * KP + 8 * c8) * 2, rdst = A_K0 + ((tid >> 2) * KP + 64 + 8 * (tid & 3)) * 2, vdst = A_V0 + (kvr * 72 + 16 * (c8 >> 1) + 4 * (c8 & 1)) * 2;
    u32x4 rk, rr, rv;
#define A_LOADK(t) do { const int tt_ = (t) < NT ? (t) : NT - 1; const size_t ro = (size_t)(tt_ * 64); rk = *(const u32x4*)(ksrc + ro * 512); if (!NA && tid < 256) rr = *(const u32x4*)(rsrc + ro * 32); } while (0)
#define A_LOADV(t) do { const int tt_ = (t) < NT ? (t) : NT - 1; rv = *(const u32x4*)(vsrc + (size_t)(tt_ * 64)); } while (0)
#define A_STOREK(b) do { *(LAS u32x4*)(lds + kdst + (b) * A_KB) = rk; if (!NA && tid < 256) *(LAS u32x4*)(lds + rdst + (b) * A_KB) = rr; } while (0)
#define A_STOREV(b) do { *(LAS u32x2*)(lds + vdst + (b) * A_VB) = (u32x2){rv.x, rv.y}; *(LAS u32x2*)(lds + vdst + (b) * A_VB + 16) = (u32x2){rv.z, rv.w}; } while (0)
    int g = 0, rs = 0, c = 0, cs = 0;
    if (NA) {
        g = g0 + (wid >> 1); rs = g - 4; rs = rs < 0 ? 0 : (rs > rows - 8 ? rows - 8 : rs);
        c = 32 * (wid & 1) + r32; cs = c - 8; cs = cs < 0 ? 0 : (cs > 48 ? 48 : cs);
        LAS float* tbl = (LAS float*)(lds + A_TBL);
        if (tid < 465) tbl[tid] = rpb_h[tid] * LOG2E;
    }
    const unsigned lds_u = (unsigned)(uintptr_t)lds;
    const char* dk_src[2] = {nullptr, nullptr}; unsigned dk_str[2] = {0u, 0u}; const char* dv_src[2] = {nullptr, nullptr};
    {
        constexpr int CPR = NA ? 9 : 13;
#pragma unroll
        for (int j = 0; j < 2; ++j) { const int ci = 64 * (wid + 8 * j) + lane, row = (ci / CPR) & 63, col = ci % CPR;
            const bool rope = !NA && (col >= 8 && col < 12);
            dk_src[j] = rope ? (const char*)(Kr + (size_t)(seqrow0 + t0 * 64 + row) * 32 + 8 * (col - 8)) : (const char*)(Kg + (size_t)(seqrow0 + t0 * 64 + row) * 512 + h * 64 + 8 * (col & 7));
            dk_str[j] = rope ? 64u * 64u : 64u * 1024u; }
#pragma unroll
        for (int j = 0; j < 2; ++j) { const int ci = 64 * (wid + 8 * j) + lane, row = ci / 9, col = ci - 9 * row;
            dv_src[j] = (const char*)(Vt + (size_t)(h * 64 + (row & 63)) * MT + seqrow0 + t0 * 64 + 8 * (col & 7)); }
    }
#define A_DMAK(t, slot) do { const unsigned tt_ = (unsigned)((t) < NT ? (t) : NT - 1); \
        glds16(dk_src[0] + (size_t)tt_ * dk_str[0], (unsigned)__builtin_amdgcn_readfirstlane(lds_u + A_K0 + (slot) * A_KB + wid * 1024)); \
        if (NA ? wid == 0 : wid < 5) glds16(dk_src[1] + (size_t)tt_ * dk_str[1], (unsigned)__builtin_amdgcn_readfirstlane(lds_u + A_K0 + (slot) * A_KB + (wid + 8) * 1024)); } while (0)
#define A_DMAV(t, slot) do { const unsigned tt_ = (unsigned)((t) < NT ? (t) : NT - 1); \
        glds16(dv_src[0] + (size_t)tt_ * 128u, (unsigned)__builtin_amdgcn_readfirstlane(lds_u + A_V0 + (slot) * A_VB + wid * 1024)); \
        if (wid == 0) glds16(dv_src[1] + (size_t)tt_ * 128u, (unsigned)__builtin_amdgcn_readfirstlane(lds_u + A_V0 + (slot) * A_VB + 8 * 1024)); } while (0)
    const size_t qrow = (size_t)(seqrow0 + q0 + wid * 32 + r32);
    bf16x8 qr[NJ];
#pragma unroll
    for (int j = 0; j < NJ; ++j) qr[j] = *(const bf16x8*)(Q + qrow * QPITCH + h * DQK + 16 * j + 8 * hi);
    f32x16 o0, o1, negm;
#pragma unroll
    for (int r = 0; r < 16; ++r) { o0[r] = 0.f; o1[r] = 0.f; negm[r] = 0.f; }
    float mref = 0.f, lrun = 0.f;
    const LAS unsigned char* kfb = lds + A_K0 + (r32 * KP + 8 * hi) * 2;
    const LAS unsigned char* vfb = lds + A_V0 + (r32 * 72 + 8 * hi) * 2;
#define A_QK(N0, N1, b) do { const LAS unsigned char* kp_ = kfb + (b) * A_KB; \
        _Pragma("unroll") for (int j = 0; j < NJ; ++j) { \
            const bf16x8 a0_ = *(const LAS bf16x8*)(kp_ + j * 32), a1_ = *(const LAS bf16x8*)(kp_ + 32 * KP * 2 + j * 32); \
            N0 = __builtin_amdgcn_mfma_f32_32x32x16_bf16(a0_, qr[j], j == 0 ? negm : N0, 0, 0, 0); \
            N1 = __builtin_amdgcn_mfma_f32_32x32x16_bf16(a1_, qr[j], j == 0 ? negm : N1, 0, 0, 0); } } while (0)
#define A_MASK(N0, N1, t) do { if (NA) { const int kr_ = t0 + (t); const bool act_ = (kr_ >= rs) && (kr_ < rs + 8) && ((t) < NT); \
        const LAS float* tb_ = (const LAS float*)(lds + A_TBL) + ((act_ ? kr_ - g + 7 : 0) * 31 + 15 - c + 4 * hi); const int kb_ = act_ ? 4 * hi - cs : -1000; \
        _Pragma("unroll") for (int r = 0; r < 16; ++r) { const int kc0 = (r & 3) + 8 * (r >> 2), kc1 = kc0 + 32; const float b0_ = tb_[kc0], b1_ = tb_[kc1]; \
            N0[r] = ((unsigned)(kb_ + kc0) < 16u) ? N0[r] + b0_ : -INFINITY; N1[r] = ((unsigned)(kb_ + kc1) < 16u) ? N1[r] + b1_ : -INFINITY; } } } while (0)
#define A_SB() __builtin_amdgcn_sched_barrier(0)
#define A_QKG(N0, N1, j) do { bf16x8 kn0_ = kf0_, kn1_ = kf1_; \
        if ((j) + 1 < NJ) { kn0_ = *(const LAS bf16x8*)(kp_ + ((j) + 1) * 32); kn1_ = *(const LAS bf16x8*)(kp_ + 32 * KP * 2 + ((j) + 1) * 32); } \
        else { kn0_ = *(const LAS bf16x8*)(vp_); kn1_ = *(const LAS bf16x8*)(vp_ + 32 * 144); } \
        N0 = __builtin_amdgcn_mfma_f32_32x32x16_bf16(kf0_, qr[j], (j) == 0 ? negm : N0, 0, 0, 0); \
        N1 = __builtin_amdgcn_mfma_f32_32x32x16_bf16(kf1_, qr[j], (j) == 0 ? negm : N1, 0, 0, 0); \
        kf0_ = kn0_; kf1_ = kn1_; } while (0)
#define A_PVG(blk) do { bf16x8 kn0_ = kf0_, kn1_ = kf1_; \
        if ((blk) + 1 < 4) { kn0_ = *(const LAS bf16x8*)(vp_ + ((blk) + 1) * 32); kn1_ = *(const LAS bf16x8*)(vp_ + 32 * 144 + ((blk) + 1) * 32); } \
        const bf16x8 pb_ = __builtin_bit_cast(bf16x8, pw_[blk]); \
        o0 = __builtin_amdgcn_mfma_f32_32x32x16_bf16(kf0_, pb_, o0, 0, 0, 0); \
        o1 = __builtin_amdgcn_mfma_f32_32x32x16_bf16(kf1_, pb_, o1, 0, 0, 0); \
        kf0_ = kn0_; kf1_ = kn1_; } while (0)
#define A_STEP(C0, C1, TMC, N0, N1, TMN, t) do { \
        const LAS unsigned char* kp_ = kfb + (((t) + 1) & 3) * A_KB; const LAS unsigned char* vp_ = vfb + ((t) & 3) * A_VB; \
        bf16x8 kf0_ = *(const LAS bf16x8*)(kp_), kf1_ = *(const LAS bf16x8*)(kp_ + 32 * KP * 2); \
        { const bool first_ = NA ? (t0 + (t) == rs) : ((t) == 0); \
          if (first_ || __any(TMC > A_THR)) { const float dl_ = first_ ? (TMC > -1e20f ? TMC : 0.f) : fmaxf(TMC, 0.f); mref += dl_; const float f_ = __builtin_amdgcn_exp2f(-dl_); lrun *= f_; \
              _Pragma("unroll") for (int r = 0; r < 16; ++r) { o0[r] *= f_; o1[r] *= f_; C0[r] -= dl_; C1[r] -= dl_; negm[r] = -mref; } } } \
        A_DMAK((t) + 3, ((t) + 3) & 3); A_DMAV((t) + 2, ((t) + 2) & 3); \
        u32x4 pw_[4]; float psa_ = 0.f, psb_ = 0.f; \
        A_SB(); \
        if constexpr (!NA) { \
            A_QKG(N0, N1, 0); g_exp<0, 6>(C0); A_SB(); \
            A_QKG(N0, N1, 1); g_exp<6, 12>(C0); g_sumpk<0, 6>(C0, psa_, psb_, pw_[0], pw_[1]); A_SB(); \
            A_QKG(N0, N1, 2); g_exp<12, 16>(C0); g_sumpk<6, 12>(C0, psa_, psb_, pw_[0], pw_[1]); A_SB(); \
            A_QKG(N0, N1, 3); g_exp<0, 6>(C1); g_sumpk<12, 16>(C0, psa_, psb_, pw_[0], pw_[1]); A_SB(); \
            A_QKG(N0, N1, 4); g_exp<6, 12>(C1); g_sumpk<0, 6>(C1, psa_, psb_, pw_[2], pw_[3]); A_SB(); \
            A_QKG(N0, N1, 5); g_exp<12, 16>(C1); g_sumpk<6, 12>(C1, psa_, psb_, pw_[2], pw_[3]); A_SB(); \
            A_PVG(0); g_sumpk<12, 16>(C1, psa_, psb_, pw_[2], pw_[3]); A_SB(); \
        } else { \
            A_QKG(N0, N1, 0); g_exp<0, 8>(C0); A_SB(); \
            A_QKG(N0, N1, 1); g_exp<8, 16>(C0); g_sumpk<0, 8>(C0, psa_, psb_, pw_[0], pw_[1]); A_SB(); \
            A_QKG(N0, N1, 2); g_exp<0, 8>(C1); g_sumpk<8, 16>(C0, psa_, psb_, pw_[0], pw_[1]); A_SB(); \
            A_QKG(N0, N1, 3); g_exp<8, 16>(C1); g_sumpk<0, 8>(C1, psa_, psb_, pw_[2], pw_[3]); A_SB(); \
            A_PVG(0); g_sumpk<8, 16>(C1, psa_, psb_, pw_[2], pw_[3]); A_SB(); \
        } \
        A_PVG(1); A_MASK(N0, N1, (t) + 1); A_SB(); \
        A_PVG(2); TMN = rowmax32(N0, N1); A_SB(); \
        A_PVG(3); lrun += psa_ + psb_; asm volatile("" :: "v"(negm));     \
        A_SB(); \
        if ((t) & 1) { asm volatile("s_waitcnt vmcnt(0)" ::: "memory"); __syncthreads(); } } while (0)

#define A_MASKR(X, r, kcoff) do { const int kc_ = ((r) & 3) + 8 * ((r) >> 2) + (kcoff); const float b_ = tb_[kc_]; X[r] = ((unsigned)(kb_ + kc_) < 16u) ? X[r] + b_ : -INFINITY; } while (0)
#define A_PVB(blk) do { const bf16x8 va0 = *(const LAS bf16x8*)(vp_ + (blk) * 32), va1 = *(const LAS bf16x8*)(vp_ + 32 * 144 + (blk) * 32); const bf16x8 pb_ = __builtin_bit_cast(bf16x8, pw_[blk]); \
        o0 = __builtin_amdgcn_mfma_f32_32x32x16_bf16(va0, pb_, o0, 0, 0, 0); o1 = __builtin_amdgcn_mfma_f32_32x32x16_bf16(va1, pb_, o1, 0, 0, 0); } while (0)
#define A_STEP_NA(C0, C1, TMC, N0, N1, TMN, t) do { \
        const int krc_ = t0 + (t); const bool actc_ = (krc_ >= rs) && (krc_ < rs + 8), actn_ = (krc_ + 1 >= rs) && (krc_ + 1 < rs + 8) && ((t) + 1 < NT); \
        A_DMAK((t) + 3, ((t) + 3) & 3); A_DMAV((t) + 2, ((t) + 2) & 3); \
        if (actc_) { const bool first_ = (krc_ == rs); \
          if (first_ || __any(TMC > A_THR)) { const float dl_ = first_ ? TMC : fmaxf(TMC, 0.f); mref += dl_; const float f_ = __builtin_amdgcn_exp2f(-dl_); lrun *= f_; \
              _Pragma("unroll") for (int r = 0; r < 16; ++r) { o0[r] *= f_; o1[r] *= f_; C0[r] -= dl_; C1[r] -= dl_; negm[r] = -mref; } } } \
        if (actn_) { A_QK(N0, N1, ((t) + 1) & 3); \
            const LAS float* tb_ = (const LAS float*)(lds + A_TBL) + ((krc_ + 1 - g + 7) * 31 + 15 - c + 4 * hi); const int kb_ = 4 * hi - cs; \
            if ((wid & 1) == 0) { \
                _Pragma("unroll") for (int r = 0; r < 16; ++r) A_MASKR(N0, r, 0); \
                _Pragma("unroll") for (int r = 0; r < 4; ++r) A_MASKR(N1, r, 32); \
                _Pragma("unroll") for (int r = 4; r < 16; ++r) N1[r] = -INFINITY; \
            } else { \
                _Pragma("unroll") for (int r = 0; r < 12; ++r) N0[r] = -INFINITY; \
                _Pragma("unroll") for (int r = 12; r < 16; ++r) A_MASKR(N0, r, 0); \
                _Pragma("unroll") for (int r = 0; r < 16; ++r) A_MASKR(N1, r, 32); \
            } \
            TMN = rowmax32(N0, N1); } \
        if (actc_) { float ps_ = 0.f; u32x4 pw_[4]; const LAS unsigned char* vp_ = vfb + ((t) & 3) * A_VB; \
            if ((wid & 1) == 0) { \
                _Pragma("unroll") for (int r = 0; r < 16; ++r) { C0[r] = __builtin_amdgcn_exp2f(C0[r]); ps_ += C0[r]; } \
                _Pragma("unroll") for (int r = 0; r < 4; ++r) { C1[r] = __builtin_amdgcn_exp2f(C1[r]); ps_ += C1[r]; } \
                pw_[0] = (u32x4){pk2(C0[0], C0[1]), pk2(C0[2], C0[3]), pk2(C0[4], C0[5]), pk2(C0[6], C0[7])}; \
                pw_[1] = (u32x4){pk2(C0[8], C0[9]), pk2(C0[10], C0[11]), pk2(C0[12], C0[13]), pk2(C0[14], C0[15])}; \
                pw_[2] = (u32x4){pk2(C1[0], C1[1]), pk2(C1[2], C1[3]), 0u, 0u}; \
                A_PVB(0); A_PVB(1); A_PVB(2); \
            } else { \
                _Pragma("unroll") for (int r = 12; r < 16; ++r) { C0[r] = __builtin_amdgcn_exp2f(C0[r]); ps_ += C0[r]; } \
                _Pragma("unroll") for (int r = 0; r < 16; ++r) { C1[r] = __builtin_amdgcn_exp2f(C1[r]); ps_ += C1[r]; } \
                pw_[1] = (u32x4){0u, 0u, pk2(C0[12], C0[13]), pk2(C0[14], C0[15])}; \
                pw_[2] = (u32x4){pk2(C1[0], C1[1]), pk2(C1[2], C1[3]), pk2(C1[4], C1[5]), pk2(C1[6], C1[7])}; \
                pw_[3] = (u32x4){pk2(C1[8], C1[9]), pk2(C1[10], C1[11]), pk2(C1[12], C1[13]), pk2(C1[14], C1[15])}; \
                A_PVB(1); A_PVB(2); A_PVB(3); \
            } \
            lrun += ps_; } \
        if ((t) & 1) { asm volatile("s_waitcnt vmcnt(0)" ::: "memory"); __syncthreads(); } } while (0)

    { A_DMAK(0, 0); A_DMAV(0, 0); A_DMAK(1, 1); A_DMAK(2, 2); A_DMAV(1, 1); }
    asm volatile("s_waitcnt vmcnt(0)" ::: "memory");
    __syncthreads();
    f32x16 sA0, sA1, sB0, sB1; float tmA, tmB;
    A_QK(sA0, sA1, 0);
    A_MASK(sA0, sA1, 0);
    tmA = rowmax32(sA0, sA1);
    __syncthreads();
    if constexpr (NA) {
        for (int t = 0; t < NT; t += 2) {
            A_STEP_NA(sA0, sA1, tmA, sB0, sB1, tmB, t);
            if (t + 1 < NT) A_STEP_NA(sB0, sB1, tmB, sA0, sA1, tmA, t + 1);
        }
        if (NT & 1) { asm volatile("s_waitcnt vmcnt(0)" ::: "memory"); __syncthreads(); }
    } else {
        for (int t = 0; t < NT; t += 2) {
            A_STEP(sA0, sA1, tmA, sB0, sB1, tmB, t);
            A_STEP(sB0, sB1, tmB, sA0, sA1, tmA, t + 1);
        }
    }
    const float lt = lrun + __shfl_xor(lrun, 32);
    const float inv = 1.0f / lt;
    bf16_t* orow = O + qrow * 512 + h * 64 + 4 * hi;
#pragma unroll
    for (int gq = 0; gq < 4; ++gq) {
        u32x2 w0, w1;
        w0.x = pk2(o0[4 * gq] * inv, o0[4 * gq + 1] * inv); w0.y = pk2(o0[4 * gq + 2] * inv, o0[4 * gq + 3] * inv);
        w1.x = pk2(o1[4 * gq] * inv, o1[4 * gq + 1] * inv); w1.y = pk2(o1[4 * gq + 2] * inv, o1[4 * gq + 3] * inv);
        *(u32x2*)(orow + 8 * gq) = w0; *(u32x2*)(orow + 32 + 8 * gq) = w1;
    }
#undef A_LOADK
#undef A_LOADV
#undef A_STOREK
#undef A_STOREV
#undef A_QK
#undef A_MASK
#undef A_STEP
#undef A_DMAK
#undef A_DMAV
#undef A_STEP_NA
#undef A_MASKR
#undef A_PVB
#undef A_SB
#undef A_QKG
#undef A_PVG
}

template <class Map>
__device__ __forceinline__ void transpose_item(const float* W, int ldw, int K, int N, bf16_t* WT, const float* gain, LAS float* scr, int item, int lane, Map map) {
    const int nblk = N / 32, kb = item / nblk, nb = item % nblk, k0 = 64 * kb, n0 = 32 * nb;
    const int src = map(n0 + (lane & 31));
#pragma unroll 8
    for (int i = 0; i < 32; ++i) { const int kk = 2 * i + (lane >> 5); float v = 0.f; if (src >= 0) { v = W[(size_t)(k0 + kk) * ldw + src]; if (gain) v *= gain[k0 + kk]; } scr[kk * 33 + (lane & 31)] = v; }
    asm volatile("s_waitcnt lgkmcnt(0)" ::: "memory");
    const int c = lane & 7;
#pragma unroll
    for (int j = 0; j < 4; ++j) { const int n = (lane >> 3) + 8 * j; const LAS float* s = scr + (8 * c) * 33 + n;
        u32x4 o; o.x = pk2(s[0 * 33], s[1 * 33]); o.y = pk2(s[2 * 33], s[3 * 33]); o.z = pk2(s[4 * 33], s[5 * 33]); o.w = pk2(s[6 * 33], s[7 * 33]);
        *(u32x4*)(WT + (size_t)(n0 + n) * K + k0 + 8 * c) = o; }
    asm volatile("s_waitcnt lgkmcnt(0)" ::: "memory");
}
__device__ __forceinline__ float2 rope_cs(int pos, int i) {
    const int a = i & 3, b = i >> 2;
    const double cf = a == 0 ? 1.0 : a == 1 ? 0.5623413251903491 : a == 2 ? 0.31622776601683794 : 0.1778279410038923;
    const double sf = b == 0 ? 1.0 : b == 1 ? 0.1 : b == 2 ? 0.01 : 0.001;
    double rev = (double)pos * (cf * sf) * 0.15915494309189535;
    rev -= __builtin_floor(rev);
    const float fr = (float)rev;
    return make_float2(__builtin_amdgcn_cosf(fr), __builtin_amdgcn_sinf(fr));
}
__device__ __forceinline__ int rope_perm(int p) { return 16 * ((p >> 2) & 1) + 4 * (p >> 3) + (p & 3); }

#define XB_TMO      128
#define XB_XCNT(j)  (256  + 64 * (j))
#define XB_XSUB(j)  (1280 + 64 * (j))
#define XB_XGEN(j)  (2304 + 64 * (j))
#define XB_TOP      3328
#define XB_TOPGEN   3392
#define XCD_BAR_WORDS 3456
#define XB_SPIN_CAP (1u << 18)

__device__ __forceinline__ unsigned xb_ld(unsigned* p)              { return __hip_atomic_load(p, __ATOMIC_RELAXED, __HIP_MEMORY_SCOPE_AGENT); }
__device__ __forceinline__ unsigned xb_add(unsigned* p, unsigned v) { return __hip_atomic_fetch_add(p, v, __ATOMIC_RELAXED, __HIP_MEMORY_SCOPE_AGENT); }
__device__ __forceinline__ unsigned xb_xcc_id() { return (unsigned)__builtin_amdgcn_s_getreg((3 << 11) | 20) & 0xFu; }
#define XB_SPIN(cond, bar) do { unsigned _sp = 0; while (cond) { __builtin_amdgcn_s_sleep(1); \
    if ((++_sp & 255u) == 0u) { if (xb_ld(&(bar)[XB_TMO])) break; if (_sp > XB_SPIN_CAP) { atomicAdd(&(bar)[XB_TMO], 1u); break; } } } } while (0)

struct XcdBarrier {
    unsigned* bar; unsigned x;
    volatile LAS unsigned* st;
};

__device__ __forceinline__ XcdBarrier xcd_barrier_post(unsigned* bar, volatile LAS unsigned* st) {
    XcdBarrier b; b.bar = bar; b.x = xb_xcc_id(); b.st = st;
    if (threadIdx.x == 0) (void)xb_add(&bar[XB_XCNT(b.x)], 1u);
    return b;
}
__device__ __forceinline__ void xcd_barrier_complete(unsigned* bar, unsigned x, unsigned& nloc, unsigned& nx) {
    const unsigned G = gridDim.x * gridDim.y * gridDim.z;
    unsigned sum, cnt, mine, sp = 0u;
    for (;;) {
        sum = 0u; cnt = 0u; mine = 0u;
#pragma unroll
        for (unsigned j = 0; j < 16; ++j) { const unsigned c = xb_ld(&bar[XB_XCNT(j)]); sum += c; cnt += (c > 0u) ? 1u : 0u; mine = (j == x) ? c : mine; }
        if (sum == G) break;
        __builtin_amdgcn_s_sleep(1);
        if ((++sp & 255u) == 0u) { if (xb_ld(&bar[XB_TMO])) break; if (sp > XB_SPIN_CAP) { atomicAdd(&bar[XB_TMO], 1u); break; } }
    }
    nloc = mine > 0u ? mine : 1u; nx = cnt > 0u ? cnt : 1u;
}

__device__ __forceinline__ void xcd_barrier(const XcdBarrier& b) {
    asm volatile("s_waitcnt vmcnt(0)" ::: "memory");
    __syncthreads();
    if (threadIdx.x == 0) {
        unsigned* bar = b.bar;
        __builtin_amdgcn_s_waitcnt(0);
        unsigned nloc = b.st[0], nx = b.st[1];
        if (nloc == 0u) { xcd_barrier_complete(bar, b.x, nloc, nx); b.st[0] = nloc; b.st[1] = nx; }
        const unsigned old = xb_add(&bar[XB_XSUB(b.x)], 1u);
        const unsigned gen = old / nloc;
        if (old + 1u == (gen + 1u) * nloc) {
            __builtin_amdgcn_fence(__ATOMIC_RELEASE, "agent");
            asm volatile("s_waitcnt vmcnt(0)" ::: "memory");
            const unsigned og = xb_add(&bar[XB_TOP], 1u);
            const unsigned tg = og / nx;
            if (og + 1u == (tg + 1u) * nx) xb_add(&bar[XB_TOPGEN], 1u);
            else XB_SPIN(xb_ld(&bar[XB_TOPGEN]) == tg, bar);
            __builtin_amdgcn_fence(__ATOMIC_ACQUIRE, "agent");
            xb_add(&bar[XB_XGEN(b.x)], 1u);
            asm volatile("s_waitcnt vmcnt(0)" ::: "memory");
        } else {
            XB_SPIN(xb_ld(&bar[XB_XGEN(b.x)]) == gen, bar);
            __builtin_amdgcn_fence(__ATOMIC_ACQUIRE, "agent");
            asm volatile("s_waitcnt vmcnt(0)" ::: "memory");
        }
    }
    __syncthreads();
}

#define Wt_in ((bf16_t*)(kp->ws + W_IN))
#define Wt_vna ((bf16_t*)(kp->ws + W_VNA))
#define Wt_uq ((bf16_t*)(kp->ws + W_UQ))
#define Wt_uk ((bf16_t*)(kp->ws + W_UK))
#define Wt_uv ((bf16_t*)(kp->ws + W_UV))
#define Wt_nao ((bf16_t*)(kp->ws + W_NAO))
#define Wt_mlao ((bf16_t*)(kp->ws + W_MLAO))
#define Wt_out ((bf16_t*)(kp->ws + W_OUT))
#define Wt_gu ((bf16_t*)(kp->ws + W_GU))
#define Wt_dn ((bf16_t*)(kp->ws + W_DN))
#define Wt_pg ((bf16_t*)(kp->ws + W_PG))
#define Wt_pl ((bf16_t*)(kp->ws + W_PL))
#define ropetab ((float2*)(kp->ws + WS_ROPE))
#define rsq1 ((float*)(kp->ws + WS_RSQ))
#define krope ((bf16_t*)(kp->ws + WS_KROPE))
#define PB ((bf16_t*)(kp->ws + WS_PB))
#define XN ((bf16_t*)(kp->ws + WS_XN))
#define QNA ((bf16_t*)(kp->ws + WS_QNA))
#define KNA ((bf16_t*)(kp->ws + WS_KNA))
#define VTNA ((bf16_t*)(kp->ws + WS_VTNA))
#define ZLAT ((bf16_t*)(kp->ws + WS_ZLAT))
#define ZQN ((bf16_t*)(kp->ws + WS_ZQN))
#define ZKVN ((bf16_t*)(kp->ws + WS_ZKVN))
#define QM ((bf16_t*)(kp->ws + WS_QM))
#define KN ((bf16_t*)(kp->ws + WS_KN))
#define VTM ((bf16_t*)(kp->ws + WS_VTM))
#define MLAO ((bf16_t*)(kp->ws + WS_MLAO))
#define T1 ((bf16_t*)(kp->ws + WS_T1))
#define U ((bf16_t*)(kp->ws + WS_U))
#define XB1 ((bf16_t*)(kp->ws + WS_XB1))
#define HB ((bf16_t*)(kp->ws + WS_H))
#define XB2 ((bf16_t*)(kp->ws + WS_XB2))
#define PW ((bf16_t*)(kp->ws + WS_PW))
#define X3B ((bf16_t*)(kp->ws + 476 * MiB))
#define rsqQ (rsq1 + 3 * MT)
#define rsqKV (rsq1 + 4 * MT)
#define rsq2 (rsq1 + MT)
#define rsq3 (rsq1 + 2 * MT)
#define NAO QNA
#define GATES ((bf16_t*)kp->out)

typedef const __attribute__((address_space(4))) Params KParams;
__device__ __forceinline__ KParams* kparams() { unsigned long long p = (unsigned long long)__builtin_amdgcn_kernarg_segment_ptr(); asm volatile("" : "+s"(p)); return (KParams*)p; }
#define KP_RELOAD kp = kparams()
__global__ void __launch_bounds__(512, 2) fwd_kernel(Params P) {
    extern __shared__ __attribute__((aligned(16))) unsigned char lds_raw[];
    LAS unsigned char* lds = (LAS unsigned char*)lds_raw;
    cg::grid_group grid = cg::this_grid();
    const KParams* kp;
    KP_RELOAD;
    { volatile LAS unsigned* st0 = (volatile LAS unsigned*)(lds + LDS_BYTES - 64); if (threadIdx.x < 16) st0[threadIdx.x] = 0u; __syncthreads(); }
    const XcdBarrier xbar = xcd_barrier_post((unsigned*)(kp->ws + WS_CTL), (volatile LAS unsigned*)(lds + LDS_BYTES - 64));

    const int wave = __builtin_amdgcn_readfirstlane(threadIdx.x >> 6);
    const int G = gridDim.x, bx = blockIdx.x;
    const int vcu = (G % 8 == 0) ? (bx % 8) * (G / 8) + bx / 8 : bx;
    const int gw = vcu * 8 + wave, NGW = G * 8;
    KP_RELOAD;
    if constexpr (PHASES & 1) {
        const int lane = my_lane();
        LAS float* scr = (LAS float*)(lds + wave * 16384);
        constexpr int I_IN = 16 * (NIN / 32), I_VNA = 16 * 16, I_UQ = 6 * 24, I_UK = 4 * 16, I_UV = 4 * 16, I_NAO = 8 * 32, I_MLAO = 8 * 32, I_OUT = 16 * 32, I_GU = 16 * 176, I_DN = 44 * 32, I_PG = 16 * 32, I_PL = 4 * 32;
        constexpr int NITEMS = I_IN + I_VNA + I_UQ + I_UK + I_UV + I_NAO + I_MLAO + I_OUT + I_GU + I_DN + I_PG + I_PL;
        for (int it = gw; it < NITEMS; it += NGW) {
            int r = it;
            if (r < I_IN) { transpose_item(kp->w_in, 4256, 1024, NIN, Wt_in, nullptr, scr, r, lane, [](int n) { if (n < 1024) return n; if (n < 3072) return 2208 + (n - 1024); const int t = n - 3072; return t < 672 ? 1536 + t : -1; }); continue; } r -= I_IN;
            if (r < I_VNA) { transpose_item(kp->w_in, 4256, 1024, 512, Wt_vna, nullptr, scr, r, lane, [](int n) { return 1024 + n; }); continue; } r -= I_VNA;
            if (r < I_UQ) { transpose_item(kp->w_uq, 768, 384, 768, Wt_uq, kp->g_q, scr, r, lane, [](int n) { const int hh = n / 96, rr = n % 96; return rr < 64 ? n : hh * 96 + 64 + rope_perm(rr - 64); }); continue; } r -= I_UQ;
            if (r < I_UK) { transpose_item(kp->w_ukv, 1024, 256, 512, Wt_uk, kp->g_kv, scr, r, lane, [](int n) { return (n >> 6) * 128 + (n & 63); }); continue; } r -= I_UK;
            if (r < I_UV) { transpose_item(kp->w_ukv, 1024, 256, 512, Wt_uv, kp->g_kv, scr, r, lane, [](int n) { return (n >> 6) * 128 + 64 + (n & 63); }); continue; } r -= I_UV;
            if (r < I_NAO) { transpose_item(kp->w_nao, 1024, 512, 1024, Wt_nao, nullptr, scr, r, lane, [](int n) { return n; }); continue; } r -= I_NAO;
            if (r < I_MLAO) { transpose_item(kp->w_mlao, 1024, 512, 1024, Wt_mlao, nullptr, scr, r, lane, [](int n) { return n; }); continue; } r -= I_MLAO;
            if (r < I_OUT) { transpose_item(kp->w_out, 1024, 1024, 1024, Wt_out, nullptr, scr, r, lane, [](int n) { return n; }); continue; } r -= I_OUT;
            if (r < I_GU) { transpose_item(kp->w_gu, 5632, 1024, 5632, Wt_gu, kp->g_ffn, scr, r, lane, [](int n) { const int j = (n >> 3) * 4 + (n & 3); return ((n >> 2) & 1) ? DFF + j : j; }); continue; } r -= I_GU;
            if (r < I_DN) { transpose_item(kp->w_dn, 1024, 2816, 1024, Wt_dn, nullptr, scr, r, lane, [](int n) { return n; }); continue; } r -= I_DN;
            if (r < I_PG) { transpose_item(kp->w_pg, 1024, 1024, 1024, Wt_pg, kp->g_ple, scr, r, lane, [](int n) { return n; }); continue; } r -= I_PG;
            transpose_item(kp->w_pl, 1024, 256, 1024, Wt_pl, nullptr, scr, r, lane, [](int n) { return n; });
        }
        {
            f32x4 gmix[4];
#pragma unroll
            for (int j = 0; j < 4; ++j) gmix[j] = *(const f32x4*)(kp->g_mix + 4 * lane + 256 * j);
            for (int m0 = gw; m0 < MT; m0 += 4 * NGW) {
                f32x4 v[4][4], pv[4];
#pragma unroll
                for (int u = 0; u < 4; ++u) { const int m = m0 + u * NGW < MT ? m0 + u * NGW : m0;
                    const float* xr = m < MP ? kp->x_p + (size_t)m * 1024 : kp->x_s + (size_t)(m - MP) * 1024;
                    const float* pr = m < MP ? kp->p_p + (size_t)m * 256 : kp->p_s + (size_t)(m - MP) * 256;
#pragma unroll
                    for (int j = 0; j < 4; ++j) v[u][j] = *(const f32x4*)(xr + 4 * lane + 256 * j);
                    pv[u] = *(const f32x4*)(pr + 4 * lane); }
#pragma unroll
                for (int u = 0; u < 4; ++u) { const int m = m0 + u * NGW < MT ? m0 + u * NGW : m0; float s = 0.f;
#pragma unroll
                    for (int j = 0; j < 4; ++j) s += (v[u][j][0] * v[u][j][0] + v[u][j][1] * v[u][j][1]) + (v[u][j][2] * v[u][j][2] + v[u][j][3] * v[u][j][3]);
                    const float rstd = __builtin_amdgcn_rsqf(wave_sum(s) * (1.0f / 1024.0f) + EPSN);
#pragma unroll
                    for (int j = 0; j < 4; ++j) { const f32x4 gg = gmix[j]; u32x2 w; w.x = pk2(v[u][j][0] * rstd * gg[0], v[u][j][1] * rstd * gg[1]); w.y = pk2(v[u][j][2] * rstd * gg[2], v[u][j][3] * rstd * gg[3]);
                        *(u32x2*)(XN + (size_t)m * 1024 + 4 * lane + 256 * j) = w; }
                    u32x2 w; w.x = pk2(pv[u][0], pv[u][1]); w.y = pk2(pv[u][2], pv[u][3]);
                    *(u32x2*)(PB + (size_t)m * 256 + 4 * lane) = w; }
            }
        }
        for (int i = gw * 64 + lane; i < SS * 16; i += NGW * 64) ropetab[i] = rope_cs(i >> 4, i & 15);
        for (int i = gw * 64 + lane; i < 5 * MT; i += NGW * 64) rsq1[i] = 0.f;
    }
    if (kp->ws == nullptr) grid.sync();
    xcd_barrier(xbar);

    KP_RELOAD;
    if constexpr (PHASES & 2) {
        pg8::Gemm g{XN, Wt_in, MT, NIN, opq(1024)}; pg8::StaticOrder S; S.init(MT, NIN, G, bx);
        EpiIn E{QNA, KNA, GATES, ZLAT, rsqQ, rsqKV};
        pg8::gemm_phase<EpiIn, pg8::StaticOrder, true, true>(lds, g, S, E, wave * 64 + my_lane());
        pg8::Gemm g2{Wt_vna, XN, 512, MT, opq(1024)}; pg8::StaticOrder S2; S2.init(512, MT, G, bx);
        EpiPlainPermT E2{VTNA, MT};
        pg8::gemm_phase<EpiPlainPermT, pg8::StaticOrder, true, true>(lds, g2, S2, E2, wave * 64 + my_lane());
    }
    xcd_barrier(xbar);

    KP_RELOAD;
    if constexpr (PHASES & 8) {
        for (int i0 = gw * 64 + my_lane(); i0 < MT * 16; i0 += 4 * NGW * 64) {
            float x1[4], x2[4]; float2 cs[4];
#pragma unroll
            for (int u = 0; u < 4; ++u) { const int i = i0 + u * NGW * 64 < MT * 16 ? i0 + u * NGW * 64 : i0; const int m = i >> 4, ii = i & 15;
                const bf16_t* zr = ZLAT + (size_t)m * 768 + 640; x1[u] = bf2f(zr[ii]); x2[u] = bf2f(zr[16 + ii]); cs[u] = ropetab[(size_t)row_pos(m) * 16 + ii]; }
#pragma unroll
            for (int u = 0; u < 4; ++u) { const int i = i0 + u * NGW * 64 < MT * 16 ? i0 + u * NGW * 64 : i0; const int m = i >> 4, ii = i & 15;
                bf16_t* ko = krope + (size_t)m * 32 + 8 * (ii >> 2) + (ii & 3);
                ko[0] = (bf16_t)(pk2(x1[u] * cs[u].x - x2[u] * cs[u].y, 0.f) & 0xffffu); ko[4] = (bf16_t)(pk2(x2[u] * cs[u].x + x1[u] * cs[u].y, 0.f) & 0xffffu); }
        }
        pg8::Gemm g{ZLAT, Wt_uq, MT, 768, opq(384), 768, 0}; pg8::StaticOrder S; S.init(MT, 768, G, bx);
        EpiQRope E{QM, ropetab, rsqQ};
        pg8::gemm_phase<EpiQRope, pg8::StaticOrder, true, true>(lds, g, S, E, wave * 64 + my_lane());
        pg8::Gemm g2{ZLAT + 384, Wt_uk, MT, 512, opq(256), 768, 0}; pg8::StaticOrder S2; S2.init(MT, 512, G, bx);
        EpiRowScale E2{KN, 512, rsqKV, 1.0f / 256.0f};
        pg8::gemm_phase<EpiRowScale, pg8::StaticOrder, true, true>(lds, g2, S2, E2, wave * 64 + my_lane());
        pg8::Gemm g3{Wt_uv, ZLAT + 384, 512, MT, opq(256), 0, 768}; pg8::StaticOrder S3; S3.init(512, MT, G, bx);
        EpiColScale E3{VTM, MT, rsqKV, 1.0f / 256.0f};
        pg8::gemm_phase<EpiColScale, pg8::StaticOrder, true, true>(lds, g3, S3, E3, wave * 64 + my_lane());
    }
    xcd_barrier(xbar);

    KP_RELOAD;
    if constexpr (PHASES & 16) {
        for (int u = vcu; u < 3072; u += G) {
            int seqrow0, h, rg, rows;
            if (u < 2048) { seqrow0 = (u >> 8) * SP; h = (u >> 5) & 7; rg = u & 31; rows = 128; }
            else { const int v = u - 2048; seqrow0 = MP + (v >> 9) * SS; h = (v >> 6) & 7; rg = v & 63; rows = 256; }
            const int g0 = 4 * rg;
            int lo = g0 - 4; lo = lo < 0 ? 0 : (lo > rows - 8 ? rows - 8 : lo);
            int hi_ = g0 - 1; hi_ = hi_ < 0 ? 0 : (hi_ > rows - 8 ? rows - 8 : hi_); hi_ += 7;
            attn_unit<true>(lds, QNA, KNA, nullptr, VTNA, NAO, h, seqrow0, 256 * rg, lo, hi_ - lo + 1, rows, g0, kp->rpb + h * 465, wave);
        }
        for (int u = vcu; u < 2048; u += G) {
            const int pair = u >> 5, qb = u & 31;
            attn_unit<false>(lds, QM, KN, krope, VTM, MLAO, pair & 7, (pair >> 3) * SP, 256 * qb, 0, SP / 64, 0, 0, nullptr, wave);
        }
        for (int u = vcu; u < 1024; u += G) {
            const int pair = u >> 6, qb = u & 63;
            attn_unit<false>(lds, QM, KN, krope, VTM, MLAO, pair & 7, MP + (pair >> 3) * SS, 256 * qb, 0, SS / 64, 0, 0, nullptr, wave);
        }
    }
    xcd_barrier(xbar);

    KP_RELOAD;
    if constexpr (PHASES & 32) {
        pg8::Gemm g{NAO, Wt_nao, MT, 1024, opq(512), 0, 0, MLAO, Wt_mlao}; pg8::DualOrder S; S.b.init(MT, 1024, G, bx);
        EpiGateDual E{U, GATES};
        pg8::gemm_phase<EpiGateDual, pg8::DualOrder, true, true>(lds, g, S, E, wave * 64 + my_lane());
    }
    xcd_barrier(xbar);

    KP_RELOAD;
    if constexpr (PHASES & 64) {
        pg8::Gemm g{U, Wt_out, MT, 1024, opq(1024)}; pg8::StaticOrder S; S.init(MT, 1024, G, bx);
        EpiResid<false> E{kp->x_p, kp->x_s, nullptr, XB1, rsq1};
        pg8::gemm_phase<EpiResid<false>, pg8::StaticOrder, true, true>(lds, g, S, E, wave * 64 + my_lane());
    }
    xcd_barrier(xbar);

    KP_RELOAD;
    if constexpr (PHASES & 128) {
        pg8::Gemm g{XB1, Wt_gu, MT, 5632, opq(1024)}; pg8::StaticOrder S; S.init(MT, 5632, G, bx);
        EpiGLU E{HB, rsq1};
        pg8::gemm_phase<EpiGLU, pg8::StaticOrder, true, true>(lds, g, S, E, wave * 64 + my_lane());
    }
    xcd_barrier(xbar);

    KP_RELOAD;
    if constexpr (PHASES & 256) {
        pg8::Gemm g{HB, Wt_dn, MT, 1024, opq(DFF)}; pg8::StaticOrder S; S.init(MT, 1024, G, bx);
        EpiResid<true> E{nullptr, nullptr, XB1, XB2, rsq2};
        pg8::gemm_phase<EpiResid<true>, pg8::StaticOrder, true, true>(lds, g, S, E, wave * 64 + my_lane());
    }
    xcd_barrier(xbar);

    KP_RELOAD;
    if constexpr (PHASES & 512) {
        pg8::Gemm g{PB, Wt_pl, MT, 1024, opq(256)}; pg8::StaticOrder S; S.init(MT, 1024, G, bx);
        EpiPlain E{PW, 1024};
        pg8::gemm_phase<EpiPlain, pg8::StaticOrder, true, true>(lds, g, S, E, wave * 64 + my_lane());
        pg8::Gemm g2{XB2, Wt_pg, MT, 1024, opq(1024)};
        EpiPle E2{XB2, X3B, PW, rsq2, rsq3};
        pg8::gemm_phase<EpiPle, pg8::StaticOrder, true, true>(lds, g2, S, E2, wave * 64 + my_lane());
    }
    xcd_barrier(xbar);

    KP_RELOAD;
    if constexpr (PHASES & 1024) {
        const int lane = my_lane();
        f32x4 gfin[4];
#pragma unroll
        for (int j = 0; j < 4; ++j) gfin[j] = *(const f32x4*)(kp->g_fin + 4 * lane + 256 * j);
        for (int m0 = gw; m0 < MT; m0 += 4 * NGW) {
            u32x2 v[4][4]; float rq[4];
#pragma unroll
            for (int u = 0; u < 4; ++u) { const int m = m0 + u * NGW < MT ? m0 + u * NGW : m0; rq[u] = rsq3[m];
#pragma unroll
                for (int j = 0; j < 4; ++j) v[u][j] = *(const u32x2*)(X3B + (size_t)m * 1024 + 4 * lane + 256 * j); }
#pragma unroll
            for (int u = 0; u < 4; ++u) { const int m = m0 + u * NGW < MT ? m0 + u * NGW : m0; if (u > 0 && m == m0) continue; const float rstd = __builtin_amdgcn_rsqf(rq[u] * (1.0f / 1024.0f) + EPSN);
#pragma unroll
                for (int j = 0; j < 4; ++j) { const f32x4 x = (f32x4){bflo(v[u][j].x), bfhi(v[u][j].x), bflo(v[u][j].y), bfhi(v[u][j].y)};
                    *(f32x4*)(kp->out + (size_t)m * 1024 + 4 * lane + 256 * j) = x * rstd * gfin[j]; } }
        }
    }
}

#undef Wt_in
#undef Wt_vna
#undef Wt_uq
#undef Wt_uk
#undef Wt_uv
#undef Wt_nao
#undef Wt_mlao
#undef Wt_out
#undef Wt_gu
#undef Wt_dn
#undef Wt_pg
#undef Wt_pl
#undef ropetab
#undef rsq1
#undef krope
#undef PB
#undef XN
#undef QNA
#undef KNA
#undef VTNA
#undef ZLAT
#undef ZQN
#undef ZKVN
#undef QM
#undef KN
#undef VTM
#undef MLAO
#undef T1
#undef U
#undef XB1
#undef HB
#undef XB2
#undef PW
#undef X3B
#undef rsqQ
#undef rsqKV
#undef rsq2
#undef rsq3
#undef NAO
#undef GATES

extern "C" void kernel_launch(void* const* d_in, const int* in_sizes, int n_in, void* d_out, int out_size, void* d_ws, size_t ws_size, hipStream_t stream) {
    static int grid_blocks = 0;
    if (grid_blocks == 0) {
        if (n_in != 21 || out_size != MT * DM || ws_size < WS_NEED) { fprintf(stderr, "kernel_launch: unexpected shapes (n_in %d out %d ws %zu)\n", n_in, out_size, ws_size); grid_blocks = -1; return; }
        int dev = 0, cus = 0, per_cu = 0;
        hipGetDevice(&dev);
        hipDeviceGetAttribute(&cus, hipDeviceAttributeMultiprocessorCount, dev);
        hipFuncSetAttribute((const void*)fwd_kernel, hipFuncAttributeMaxDynamicSharedMemorySize, LDS_BYTES);
        hipOccupancyMaxActiveBlocksPerMultiprocessor(&per_cu, (const void*)fwd_kernel, 512, LDS_BYTES);
        if (per_cu < 1) per_cu = 1;
        grid_blocks = cus * 1;
        (void)hipGetLastError();
    }
    if (grid_blocks < 0) return;
    if (hipMemsetAsync((unsigned char*)d_ws + WS_CTL, 0, CTL_BYTES, stream) != hipSuccess) { fprintf(stderr, "kernel_launch: memset failed\n"); return; }
    Params P{};
    const float** pp = (const float**)&P;
    for (int i = 0; i < 21; ++i) pp[i] = (const float*)d_in[i];
    P.out = (float*)d_out; P.ws = (unsigned char*)d_ws;
    void* args[] = {&P};
    hipError_t e = hipLaunchCooperativeKernel((const void*)fwd_kernel, dim3(grid_blocks), dim3(512), args, LDS_BYTES, stream);
    if (e != hipSuccess) fprintf(stderr, "cooperative launch failed: %s (grid %d)\n", hipGetErrorString(e), grid_blocks);
}
```

```cpp
#include <hip/hip_runtime.h>
#include <hip/hip_cooperative_groups.h>
#include <cstdio>
#include <cstdint>
namespace cg = cooperative_groups;
namespace pg8 {
#define PG8_LAS __attribute__((address_space(3)))
typedef unsigned short bf16_t;
typedef short bf16x8 __attribute__((ext_vector_type(8)));
typedef float f32x4 __attribute__((ext_vector_type(4)));
typedef unsigned u32x4 __attribute__((ext_vector_type(4)));
constexpr int BM = 256, BK = 64, HALF = 128, HTB = HALF * BK * 2  , STAGE_BYTES = 8 * HTB, NXCD = 8, WGM = 8;

__host__ __device__ __forceinline__ int lds_byte(int r, int c) { const int st = (r >> 4) * 2 + (c >> 5), rr = r & 15, cc = c & 31, ob = rr * 64 + cc * 2; return st * 1024 + (ob ^ (((ob >> 9) & 1) << 5)); }
__host__ __device__ __forceinline__ void stage_rc(int b, int& R, int& C) { const int st = b / 1024, sb = b % 1024, swz = sb ^ (((sb >> 9) & 1) << 5); R = (st >> 1) * 16 + swz / 64; C = (st & 1) * 32 + (swz % 64) / 2; }
__host__ __device__ __forceinline__ int perm32(int rho) { const int n = rho >> 4, i = rho & 15; return 8 * (i >> 2) + 4 * n + (i & 3); }

struct Unit { int pm, pn; int sel; };
struct Gemm { const bf16_t* A; const bf16_t* Bt; int M, N, K; int lda = 0, ldb = 0; const bf16_t* A2 = nullptr; const bf16_t* Bt2 = nullptr; };

struct StaticOrder {
    int nM, nN, nwg, G, c;
    __host__ __device__ void init(int M, int N, int G_, int c_) { nM = M / BM; nN = N / BM; nwg = nM * nN; G = G_; c = c_; }
    __host__ __device__ bool next(int i, Unit& u) const {
        const long L = (long)i * G + c; if (L >= nwg) return false;
        int wgid = (int)L; { const int q = nwg / NXCD, r = nwg % NXCD, xcd = wgid % NXCD, off = wgid / NXCD; wgid = (xcd < r ? xcd * (q + 1) : r * (q + 1) + (xcd - r) * q) + off; }
        const int nig = WGM * nN, gid = wgid / nig, fm = gid * WGM, gsz = (nM - fm) < WGM ? (nM - fm) : WGM;
        u.pm = fm + ((wgid % nig) % gsz); u.pn = (wgid % nig) / gsz; u.sel = 0; return true;
    }
    __device__ __forceinline__ void a_ready(const Unit&) const {}
    __device__ __forceinline__ void done(const Unit&) const {}
};

struct DualOrder {
    StaticOrder b;
    __host__ __device__ bool next(int i, Unit& u) const { const bool ok = b.next(i >> 1, u); u.sel = i & 1; return ok; }
    __device__ __forceinline__ void a_ready(const Unit&) const {}
    __device__ __forceinline__ void done(const Unit&) const {}
};
__device__ __forceinline__ unsigned cvt_pk_bf16(float lo, float hi) { unsigned r; asm volatile("v_cvt_pk_bf16_f32 %0, %1, %2" : "=v"(r) : "v"(lo), "v"(hi)); return r; }
typedef float f32x2 __attribute__((ext_vector_type(2)));
template <class Epi, class Sched, bool ALIGN_EPI = false, bool SP2 = false>
__device__ __forceinline__ void gemm_phase(PG8_LAS unsigned char* lds, const Gemm g, const Sched& S, const Epi& E, int tid_in) {
    int tid_ = tid_in; asm volatile("" : "+v"(tid_));
    const int tid = tid_, wid = __builtin_amdgcn_readfirstlane(tid >> 6), lane = tid & 63, wr = wid >> 2, wc = wid & 3, fr = lane & 15, fq = lane >> 4;
    const int K = g.K, nt = K / BK, lda = g.lda ? g.lda : K, ldb = g.ldb ? g.ldb : K;
    unsigned voffA[2], voffB[2];
#pragma unroll
    for (int i = 0; i < 2; ++i) { int R, C; stage_rc(tid * 16 + i * 8192, R, C); const int Rb = Epi::PERM ? ((R & ~31) + perm32(R & 31)) : R;
        voffA[i] = (unsigned)(R * lda + C) * 2u; voffB[i] = (unsigned)(Rb * ldb + C) * 2u; }
    const size_t kstep = (size_t)(BK * 2);
    const size_t hstepA = (size_t)HALF * lda * 2, hstepB = (size_t)HALF * ldb * 2;
    const size_t tstepA = 2 * hstepA, tstepB = 2 * hstepB;
    const unsigned ldsw = (unsigned)wid * 1024u;
    const int aoff = lds_byte(wr * 64 + fr, fq * 8), boff = lds_byte(wc * 32 + fr, fq * 8);
#define PG8_SA(b, h) (((b) * 2 + (h)) * HTB)
#define PG8_SB(b, h) ((4 + (b) * 2 + (h)) * HTB)
#define PG8_STAGE(bufoff, gbase, voff) do { _Pragma("unroll") for (int _i = 0; _i < 2; ++_i) \
        __builtin_amdgcn_global_load_lds((const unsigned*)((const char*)(gbase) + (voff)[_i]), (PG8_LAS unsigned*)(lds + (bufoff) + ldsw + _i * 8192), 16, 0, 0); } while (0)
#define PG8_LDA(dst, b, h) do { _Pragma("unroll") for (int m = 0; m < 4; ++m) _Pragma("unroll") for (int k = 0; k < 2; ++k) dst[m][k] = *(const PG8_LAS bf16x8*)(lds + PG8_SA(b, h) + aoff + m * 2048 + k * 1024); } while (0)
#define PG8_LDB(dst, b, h) do { _Pragma("unroll") for (int n = 0; n < 2; ++n) _Pragma("unroll") for (int k = 0; k < 2; ++k) dst[n][k] = *(const PG8_LAS bf16x8*)(lds + PG8_SB(b, h) + boff + n * 2048 + k * 1024); } while (0)
#define PG8_MMA(ai, bj, At, Bt) do { __builtin_amdgcn_s_setprio(1); _Pragma("unroll") for (int m = 0; m < 4; ++m) _Pragma("unroll") for (int n = 0; n < 2; ++n) _Pragma("unroll") for (int k = 0; k < 2; ++k) \
        acc[ai][bj][m][n] = __builtin_amdgcn_mfma_f32_16x16x32_bf16(Bt[n][k], At[m][k], acc[ai][bj][m][n], 0, 0, 0); __builtin_amdgcn_s_setprio(0); } while (0)
#define PG8_WAIT_V(n) asm volatile("s_waitcnt vmcnt(" #n ")" ::: "memory")
#define PG8_WAIT_L(n) asm volatile("s_waitcnt lgkmcnt(" #n ")" ::: "memory")
#define PG8_BAR __builtin_amdgcn_s_barrier()
#define PG8_SCHED __builtin_amdgcn_sched_barrier(0)
    Unit cur, nxt; int ui = 0;
    if (!S.next(0, cur)) return;
    f32x4 acc[2][2][4][2];
#pragma unroll
    for (int a = 0; a < 2; ++a)
#pragma unroll
        for (int b = 0; b < 2; ++b)
#pragma unroll
            for (int m = 0; m < 4; ++m)
#pragma unroll
                for (int n = 0; n < 2; ++n) acc[a][b][m][n] = (f32x4){0.f, 0.f, 0.f, 0.f};
    bf16x8 At[4][2], B0[2][2], B1[2][2];
    const char* cA = (const char*)(cur.sel ? g.A2 : g.A) + (size_t)cur.pm * tstepA; const char* cB = (const char*)(cur.sel ? g.Bt2 : g.Bt) + (size_t)cur.pn * tstepB;
    S.a_ready(cur);
    if constexpr (SP2) {
        PG8_STAGE(PG8_SB(0, 0), cB, voffB); PG8_STAGE(PG8_SB(0, 1), cB + hstepB, voffB); PG8_STAGE(PG8_SA(0, 0), cA, voffA); PG8_STAGE(PG8_SA(0, 1), cA + hstepA, voffA);
        if (wr == 1) PG8_BAR;
        PG8_WAIT_V(2); PG8_BAR;
        PG8_STAGE(PG8_SB(1, 0), cB + kstep, voffB); PG8_STAGE(PG8_SA(1, 0), cA + kstep, voffA); PG8_STAGE(PG8_SB(1, 1), cB + hstepB + kstep, voffB);
        PG8_WAIT_V(6); PG8_BAR;
    } else {
        PG8_STAGE(PG8_SB(0, 0), cB, voffB); PG8_STAGE(PG8_SA(0, 0), cA, voffA); PG8_STAGE(PG8_SB(0, 1), cB + hstepB, voffB); PG8_STAGE(PG8_SA(0, 1), cA + hstepA, voffA);
        if (wr == 1) PG8_BAR;
        PG8_WAIT_V(4); PG8_BAR;
        PG8_STAGE(PG8_SB(1, 0), cB + kstep, voffB); PG8_STAGE(PG8_SA(1, 0), cA + kstep, voffA); PG8_STAGE(PG8_SB(1, 1), cB + hstepB + kstep, voffB);
        PG8_WAIT_V(6); PG8_BAR;
    }
    for (;;) {
        const bool has_next = S.next(ui + 1, nxt);
        const char* nA = has_next ? (const char*)(nxt.sel ? g.A2 : g.A) + (size_t)nxt.pm * tstepA : cA; const char* nB = has_next ? (const char*)(nxt.sel ? g.Bt2 : g.Bt) + (size_t)nxt.pn * tstepB : cB;
        for (int t = 0; t < nt; t += 2) {
            const bool last = (t == nt - 2);
            const char* a1 = cA + (size_t)(t + 1) * kstep;
            const char* a2 = last ? nA : cA + (size_t)(t + 2) * kstep; const char* b2 = last ? nB : cB + (size_t)(t + 2) * kstep;
            const char* a3 = a2 + kstep; const char* b3 = b2 + kstep;
            if (last && has_next) S.a_ready(nxt);
            if constexpr (SP2) {
            PG8_LDB(B0, 0, 0); PG8_LDB(B1, 0, 1); PG8_SCHED; PG8_LDA(At, 0, 0); PG8_STAGE(PG8_SA(1, 1), a1 + hstepA, voffA);
            PG8_WAIT_V(8); PG8_WAIT_L(0); PG8_BAR; PG8_MMA(0, 0, At, B0); PG8_MMA(0, 1, At, B1); PG8_BAR; PG8_SCHED;
            PG8_LDA(At, 0, 1); PG8_STAGE(PG8_SB(0, 0), b2, voffB); PG8_STAGE(PG8_SB(0, 1), b2 + hstepB, voffB); PG8_STAGE(PG8_SA(0, 0), a2, voffA);
            PG8_WAIT_V(8); PG8_WAIT_L(0); PG8_BAR; PG8_MMA(1, 0, At, B0); PG8_MMA(1, 1, At, B1); PG8_BAR; PG8_SCHED;
            PG8_LDB(B0, 1, 0); PG8_LDB(B1, 1, 1); PG8_SCHED; PG8_LDA(At, 1, 0); PG8_STAGE(PG8_SA(0, 1), a2 + hstepA, voffA);
            PG8_WAIT_V(8); PG8_WAIT_L(0); PG8_BAR; PG8_MMA(0, 0, At, B0); PG8_MMA(0, 1, At, B1); PG8_BAR; PG8_SCHED;
            PG8_LDA(At, 1, 1); PG8_STAGE(PG8_SB(1, 0), b3, voffB); PG8_STAGE(PG8_SB(1, 1), b3 + hstepB, voffB); PG8_STAGE(PG8_SA(1, 0), a3, voffA);
            PG8_WAIT_V(8); PG8_WAIT_L(0); PG8_BAR; PG8_MMA(1, 0, At, B0); PG8_MMA(1, 1, At, B1); PG8_BAR; PG8_SCHED;
            } else {
            PG8_LDB(B0, 0, 0); PG8_SCHED; PG8_LDA(At, 0, 0); PG8_STAGE(PG8_SA(1, 1), a1 + hstepA, voffA);
            PG8_WAIT_L(8); PG8_BAR; PG8_WAIT_L(0); PG8_MMA(0, 0, At, B0); PG8_BAR; PG8_SCHED;
            PG8_LDB(B1, 0, 1); PG8_STAGE(PG8_SB(0, 0), b2, voffB);
            PG8_BAR; PG8_WAIT_L(0); PG8_MMA(0, 1, At, B1); PG8_BAR;
            PG8_LDA(At, 0, 1); PG8_STAGE(PG8_SA(0, 0), a2, voffA);
            PG8_BAR; PG8_WAIT_L(0); PG8_MMA(1, 0, At, B0); PG8_BAR; PG8_SCHED;
            PG8_STAGE(PG8_SB(0, 1), b2 + hstepB, voffB);
            PG8_WAIT_V(6); PG8_BAR; PG8_MMA(1, 1, At, B1); PG8_BAR;
            PG8_LDB(B0, 1, 0); PG8_SCHED; PG8_LDA(At, 1, 0); PG8_STAGE(PG8_SA(0, 1), a2 + hstepA, voffA);
            PG8_WAIT_L(8); PG8_BAR; PG8_WAIT_L(0); PG8_MMA(0, 0, At, B0); PG8_BAR; PG8_SCHED;
            PG8_LDB(B1, 1, 1); PG8_STAGE(PG8_SB(1, 0), b3, voffB);
            PG8_BAR; PG8_WAIT_L(0); PG8_MMA(0, 1, At, B1); PG8_BAR;
            PG8_LDA(At, 1, 1); PG8_STAGE(PG8_SA(1, 0), a3, voffA);
            PG8_BAR; PG8_WAIT_L(0); PG8_MMA(1, 0, At, B0); PG8_BAR; PG8_SCHED;
            PG8_STAGE(PG8_SB(1, 1), b3 + hstepB, voffB);
            PG8_WAIT_V(6); PG8_BAR; PG8_MMA(1, 1, At, B1); PG8_BAR;
            }
        }
        if constexpr (ALIGN_EPI) { if (wr == 0) PG8_BAR; }
        if constexpr (!Epi::AFTER_DRAIN) { E(acc, cur, wr, wc, fr, fq); S.done(cur); }
        if (!has_next) break;
        if (!Epi::DUAL || cur.sel == 1) {
#pragma unroll
        for (int a = 0; a < 2; ++a)
#pragma unroll
            for (int b = 0; b < 2; ++b)
#pragma unroll
                for (int m = 0; m < 4; ++m)
#pragma unroll
                    for (int n = 0; n < 2; ++n) acc[a][b][m][n] = (f32x4){0.f, 0.f, 0.f, 0.f};
        }
        cur = nxt; cA = nA; cB = nB; ++ui;
        if constexpr (ALIGN_EPI) { if (wr == 1) PG8_BAR; }
    }
    PG8_WAIT_V(0);
    if constexpr (!ALIGN_EPI) { if (wr == 0) PG8_BAR; }
    PG8_BAR;
    if constexpr (Epi::AFTER_DRAIN) { E.fused(acc, cur, wr, wc, fr, fq, lds, wid, lane); S.done(cur); }
#undef PG8_SA
#undef PG8_SB
#undef PG8_STAGE
#undef PG8_LDA
#undef PG8_LDB
#undef PG8_MMA
#undef PG8_WAIT_V
#undef PG8_WAIT_L
#undef PG8_BAR
#undef PG8_SCHED
}
}

#define LAS __attribute__((address_space(3)))
typedef unsigned short bf16_t;
typedef short bf16x8 __attribute__((ext_vector_type(8)));
typedef short s16x4 __attribute__((ext_vector_type(4)));
typedef float f32x4 __attribute__((ext_vector_type(4)));
typedef float f32x16 __attribute__((ext_vector_type(16)));
typedef unsigned u32x4 __attribute__((ext_vector_type(4)));
typedef unsigned u32x2 __attribute__((ext_vector_type(2)));

constexpr int DM = 1024, MP = 65536, MS_ = 32768, MT = 98304, SP = 8192, SS = 16384, DFF = 2816;
constexpr int NIN = 3840;
constexpr float EPSN = 1e-6f;
constexpr float LOG2E = 1.4426950408889634f;
constexpr float QS_NA = 0.125f * LOG2E;
constexpr float QS_M = 0.10206207261596575f * LOG2E;

constexpr size_t MiB = 1u << 20;
constexpr size_t W_IN = 0, W_VNA = W_IN + (size_t)NIN * 1024 * 2, W_UQ = W_VNA + 512 * 1024 * 2, W_UK = W_UQ + 768 * 384 * 2, W_UV = W_UK + 512 * 256 * 2,
                 W_NAO = W_UV + 512 * 256 * 2, W_MLAO = W_NAO + 1024 * 512 * 2, W_OUT = W_MLAO + 1024 * 512 * 2, W_GU = W_OUT + 1024 * 1024 * 2,
                 W_DN = W_GU + (size_t)5632 * 1024 * 2, W_PG = W_DN + (size_t)1024 * 2816 * 2, W_PL = W_PG + 1024 * 1024 * 2, W_END = W_PL + 1024 * 256 * 2;
static_assert(W_END <= 34 * MiB, "weights region");
constexpr size_t WS_CTL = 33 * MiB, CTL_BYTES = 16384;
static_assert(W_END <= WS_CTL, "ctl after weights");
constexpr size_t WS_ROPE = 34 * MiB;
constexpr size_t WS_RSQ = 36 * MiB;
constexpr size_t WS_KROPE = 38 * MiB;
constexpr size_t WS_PB = 44 * MiB;
constexpr size_t WS_XN = 92 * MiB;
constexpr size_t WS_QNA = 284 * MiB, WS_KNA = 380 * MiB, WS_VTNA = 476 * MiB;
constexpr size_t WS_ZLAT = 572 * MiB;
constexpr size_t WS_ZQN = 716 * MiB, WS_ZKVN = 788 * MiB;
constexpr size_t WS_QM = 92 * MiB;
constexpr size_t WS_KN = 716 * MiB;
constexpr size_t WS_VTM = 836 * MiB;
constexpr size_t WS_MLAO = 572 * MiB;
constexpr size_t WS_T1 = 92 * MiB;
constexpr size_t WS_U = 380 * MiB;
constexpr size_t WS_XB1 = 92 * MiB;
constexpr size_t WS_H = 284 * MiB;
constexpr size_t WS_XB2 = 92 * MiB;
constexpr size_t WS_PW = 284 * MiB;
constexpr size_t WS_NEED = 932 * MiB;

#ifndef PHASES
#define PHASES 0x7ff
#endif
constexpr int LDS_BYTES = 147456;

struct Params {
    const float *x_p, *x_s, *p_p, *p_s, *g_mix, *w_in, *rpb, *g_q, *w_uq, *g_kv, *w_ukv, *w_nao, *w_mlao, *w_out, *g_ffn, *w_gu, *w_dn, *g_ple, *w_pg, *w_pl, *g_fin;
    float* out; unsigned char* ws;
};

__device__ __forceinline__ unsigned pk2(float lo, float hi) { return pg8::cvt_pk_bf16(lo, hi); }
__device__ __forceinline__ float bf2f(unsigned short b) { return __uint_as_float((unsigned)b << 16); }
__device__ __forceinline__ float bflo(unsigned w) { return __uint_as_float(w << 16); }
__device__ __forceinline__ float bfhi(unsigned w) { return __uint_as_float(w & 0xffff0000u); }
__device__ __forceinline__ float sigmoidf_(float x) { return __builtin_amdgcn_rcpf(1.0f + __builtin_amdgcn_exp2f(-x * LOG2E)); }
__device__ __forceinline__ void store8(bf16_t* p, f32x4 a, f32x4 b) { u32x4 w; w.x = pk2(a[0], a[1]); w.y = pk2(a[2], a[3]); w.z = pk2(b[0], b[1]); w.w = pk2(b[2], b[3]); *(u32x4*)p = w; }
__device__ __forceinline__ float wave_sum(float v) {
#pragma unroll
    for (int o = 1; o < 64; o <<= 1) v += __shfl_xor(v, o);
    return v;
}
__device__ __forceinline__ int opq(int v) { asm volatile("" : "+s"(v)); return v; }
__device__ __forceinline__ int my_lane() { int l; asm volatile("v_mbcnt_lo_u32_b32 %0, -1, 0\n\tv_mbcnt_hi_u32_b32 %0, -1, %0" : "=v"(l)); return l; }
__device__ __forceinline__ int row_pos(int row) { return row < MP ? (row & (SP - 1)) : (row & (SS - 1)); }

typedef f32x4 Acc[2][2][4][2];
#define EPI_ROWS(ai, m) (u.pm * 256 + (ai) * 128 + wr * 64 + (m) * 16 + fr)
#define EPI_COL(bj) (u.pn * 256 + (bj) * 128 + wc * 32 + 8 * fq)

__device__ __forceinline__ void rowsum_atomic4(float* dst, const float (&ss)[4], int row0  , int fq) {
    const float v = fq == 0 ? ss[0] : fq == 1 ? ss[1] : fq == 2 ? ss[2] : ss[3];
    unsafeAtomicAdd(dst + row0 + 16 * fq, v);
}
struct EpiIn {
    static constexpr bool PERM = true, AFTER_DRAIN = false, DUAL = false;
    bf16_t *qna, *kna, *gates, *zlat; float *rsq_q, *rsq_kv;
    __device__ __forceinline__ void operator()(const Acc& acc, const pg8::Unit& u, int wr, int wc, int fr, int fq) const {
        const int pn = u.pn; bf16_t* base; int ldc, cb, mode;
        if (pn < 2) { base = qna; ldc = 512; cb = pn * 256; mode = 1; }
        else if (pn < 4) { base = kna; ldc = 512; cb = (pn - 2) * 256; mode = 0; }
        else if (pn < 12) { base = gates; ldc = 2048; cb = (pn - 4) * 256; mode = 2; }
        else { base = zlat; ldc = 768; cb = (pn - 12) * 256; mode = 0; }
        const float sc = mode == 1 ? QS_NA : 1.0f;
#pragma unroll
        for (int ai = 0; ai < 2; ++ai) { float sq[4] = {0.f, 0.f, 0.f, 0.f}, sk[4] = {0.f, 0.f, 0.f, 0.f};
#pragma unroll
            for (int m = 0; m < 4; ++m) {
                bf16_t* rowp = base + (size_t)EPI_ROWS(ai, m) * ldc + cb + wc * 32 + 8 * fq;
#pragma unroll
                for (int bj = 0; bj < 2; ++bj) {
                    f32x4 v0 = acc[ai][bj][m][0], v1 = acc[ai][bj][m][1];
                    if (mode == 2) {
#pragma unroll
                        for (int e = 0; e < 4; ++e) { v0[e] = sigmoidf_(v0[e]); v1[e] = sigmoidf_(v1[e]); }
                    } else { v0 = v0 * sc; v1 = v1 * sc; }
                    store8(rowp + bj * 128, v0, v1);
                    if (pn >= 12) {
                        const bool isq = (pn == 12 || (pn == 13 && bj == 0)), iskv = !isq && (pn == 13 || bj == 0);
                        if (isq || iskv) { float ss = (v0[0] * v0[0] + v0[1] * v0[1]) + (v0[2] * v0[2] + v0[3] * v0[3]) + (v1[0] * v1[0] + v1[1] * v1[1]) + (v1[2] * v1[2] + v1[3] * v1[3]);
                            ss += __shfl_xor(ss, 16); ss += __shfl_xor(ss, 32);
                            if (isq) sq[m] += ss; else sk[m] += ss; }
                    }
                }
            }
            if (pn >= 12) { if (pn <= 13) rowsum_atomic4(rsq_q, sq, EPI_ROWS(ai, 0), fq); if (pn >= 13) rowsum_atomic4(rsq_kv, sk, EPI_ROWS(ai, 0), fq); }
        }
    }
};
struct EpiPlain {
    static constexpr bool PERM = true, AFTER_DRAIN = false, DUAL = false;
    bf16_t* O; int ldc;
    __device__ __forceinline__ void operator()(const Acc& acc, const pg8::Unit& u, int wr, int wc, int fr, int fq) const {
#pragma unroll
        for (int ai = 0; ai < 2; ++ai)
#pragma unroll
            for (int m = 0; m < 4; ++m) {
                bf16_t* rowp = O + (size_t)EPI_ROWS(ai, m) * ldc + EPI_COL(0);
#pragma unroll
                for (int bj = 0; bj < 2; ++bj) store8(rowp + bj * 128, acc[ai][bj][m][0], acc[ai][bj][m][1]);
            }
    }
};
struct EpiPlainPermT {
    static constexpr bool PERM = true, AFTER_DRAIN = false, DUAL = false;
    bf16_t* O; int ldc;
    __device__ __forceinline__ void operator()(const Acc& acc, const pg8::Unit& u, int wr, int wc, int fr, int fq) const {
#pragma unroll
        for (int bj = 0; bj < 2; ++bj) { const int col = EPI_COL(bj);
#pragma unroll
            for (int ai = 0; ai < 2; ++ai)
#pragma unroll
                for (int m = 0; m < 4; ++m) { const f32x4 v0 = acc[ai][bj][m][0], v1 = acc[ai][bj][m][1];
                    bf16_t* p = O + (size_t)EPI_ROWS(ai, m) * ldc + (col & ~15) + ((col & 8) ? 4 : 0);
                    u32x2 w0, w1; w0.x = pk2(v0[0], v0[1]); w0.y = pk2(v0[2], v0[3]); w1.x = pk2(v1[0], v1[1]); w1.y = pk2(v1[2], v1[3]);
                    *(u32x2*)p = w0; *(u32x2*)(p + 8) = w1; } }
    }
};
struct EpiRowScale {
    static constexpr bool PERM = true, AFTER_DRAIN = false, DUAL = false;
    bf16_t* O; int ldc; const float* rsq; float invn;
    __device__ __forceinline__ void operator()(const Acc& acc, const pg8::Unit& u, int wr, int wc, int fr, int fq) const {
        float rq[2][4];
#pragma unroll
        for (int ai = 0; ai < 2; ++ai)
#pragma unroll
            for (int m = 0; m < 4; ++m) rq[ai][m] = rsq[EPI_ROWS(ai, m)];
#pragma unroll
        for (int ai = 0; ai < 2; ++ai)
#pragma unroll
            for (int m = 0; m < 4; ++m) {
                const float rstd = __builtin_amdgcn_rsqf(rq[ai][m] * invn + EPSN);
                bf16_t* rowp = O + (size_t)EPI_ROWS(ai, m) * ldc + EPI_COL(0);
#pragma unroll
                for (int bj = 0; bj < 2; ++bj) store8(rowp + bj * 128, acc[ai][bj][m][0] * rstd, acc[ai][bj][m][1] * rstd);
            }
    }
};
struct EpiColScale {
    static constexpr bool PERM = true, AFTER_DRAIN = false, DUAL = false;
    bf16_t* O; int ldc; const float* rsq; float invn;
    __device__ __forceinline__ void operator()(const Acc& acc, const pg8::Unit& u, int wr, int wc, int fr, int fq) const {
#pragma unroll
        for (int bj = 0; bj < 2; ++bj) {
            const int col = EPI_COL(bj);
            f32x4 r0 = *(const f32x4*)(rsq + col), r1 = *(const f32x4*)(rsq + col + 4);
#pragma unroll
            for (int e = 0; e < 4; ++e) { r0[e] = __builtin_amdgcn_rsqf(r0[e] * invn + EPSN); r1[e] = __builtin_amdgcn_rsqf(r1[e] * invn + EPSN); }
#pragma unroll
            for (int ai = 0; ai < 2; ++ai)
#pragma unroll
                for (int m = 0; m < 4; ++m) {
                    const f32x4 v0 = acc[ai][bj][m][0] * r0, v1 = acc[ai][bj][m][1] * r1;
                    bf16_t* p = O + (size_t)EPI_ROWS(ai, m) * ldc + (col & ~15) + ((col & 8) ? 4 : 0);
                    u32x2 w0, w1; w0.x = pk2(v0[0], v0[1]); w0.y = pk2(v0[2], v0[3]); w1.x = pk2(v1[0], v1[1]); w1.y = pk2(v1[2], v1[3]);
                    *(u32x2*)p = w0; *(u32x2*)(p + 8) = w1; }
        }
    }
};
struct EpiQRope {
    static constexpr bool PERM = true, AFTER_DRAIN = false, DUAL = false;
    bf16_t* Qm; const float2* tab; const float* rsq;
    __device__ __forceinline__ void operator()(const Acc& acc, const pg8::Unit& u, int wr, int wc, int fr, int fq) const {
        const bool rope0 = ((u.pn * 8 + wc) % 3) == 2, rope1 = ((u.pn * 8 + 4 + wc) % 3) == 2, anyrope = rope0 || rope1;
#pragma unroll
        for (int ai = 0; ai < 2; ++ai) {
            f32x4 cs[4][2]; float rq[4];
#pragma unroll
            for (int m = 0; m < 4; ++m) rq[m] = rsq[EPI_ROWS(ai, m)];
            if (anyrope) {
#pragma unroll
                for (int m = 0; m < 4; ++m) { const f32x4* t = (const f32x4*)(tab + (size_t)row_pos(EPI_ROWS(ai, m)) * 16 + 4 * fq); cs[m][0] = t[0]; cs[m][1] = t[1]; }
            }
#pragma unroll
            for (int m = 0; m < 4; ++m) {
                const int row = EPI_ROWS(ai, m);
#pragma unroll
                for (int bj = 0; bj < 2; ++bj) {
                    const float sc = QS_M * __builtin_amdgcn_rsqf(rq[m] * (1.0f / 384.0f) + EPSN);
                    f32x4 v0 = acc[ai][bj][m][0] * sc, v1 = acc[ai][bj][m][1] * sc;
                    if (bj == 0 ? rope0 : rope1) {
#pragma unroll
                        for (int e = 0; e < 4; ++e) { const float cc = cs[m][e >> 1][2 * (e & 1)], sn = cs[m][e >> 1][2 * (e & 1) + 1]; const float a = v0[e], b = v1[e]; v0[e] = a * cc - b * sn; v1[e] = b * cc + a * sn; }
                    }
                    store8(Qm + (size_t)row * 768 + EPI_COL(bj), v0, v1);
                }
            }
            asm volatile("" ::: "memory");
        }
    }
};
struct EpiGateDual {
    static constexpr bool PERM = true, AFTER_DRAIN = false, DUAL = true;
    bf16_t* U; const bf16_t* gates;
    __device__ __forceinline__ void operator()(Acc& acc, const pg8::Unit& u, int wr, int wc, int fr, int fq) const {
        if (u.sel == 0) {
#pragma unroll
            for (int ai = 0; ai < 2; ++ai)
#pragma unroll
                for (int mp = 0; mp < 2; ++mp) {
                    u32x4 ga[2][2], gb[2][2];
#pragma unroll
                    for (int mm = 0; mm < 2; ++mm)
#pragma unroll
                        for (int bj = 0; bj < 2; ++bj) { const bf16_t* gp = gates + (size_t)EPI_ROWS(ai, 2 * mp + mm) * 2048 + EPI_COL(bj); ga[mm][bj] = *(const u32x4*)gp; gb[mm][bj] = *(const u32x4*)(gp + 1024); }
#pragma unroll
                    for (int mm = 0; mm < 2; ++mm)
#pragma unroll
                        for (int bj = 0; bj < 2; ++bj) { const int m = 2 * mp + mm; const u32x4 a = ga[mm][bj], b = gb[mm][bj];
#define RATIO_(x, y) ((x) * __builtin_amdgcn_rcpf(fmaxf((y), 1e-30f)))
                            acc[ai][bj][m][0][0] *= RATIO_(bflo(a.x), bflo(b.x)); acc[ai][bj][m][0][1] *= RATIO_(bfhi(a.x), bfhi(b.x)); acc[ai][bj][m][0][2] *= RATIO_(bflo(a.y), bflo(b.y)); acc[ai][bj][m][0][3] *= RATIO_(bfhi(a.y), bfhi(b.y));
                            acc[ai][bj][m][1][0] *= RATIO_(bflo(a.z), bflo(b.z)); acc[ai][bj][m][1][1] *= RATIO_(bfhi(a.z), bfhi(b.z)); acc[ai][bj][m][1][2] *= RATIO_(bflo(a.w), bflo(b.w)); acc[ai][bj][m][1][3] *= RATIO_(bfhi(a.w), bfhi(b.w));
#undef RATIO_
                        }
                    asm volatile("" ::: "memory");
                }
        } else {
#pragma unroll
            for (int ai = 0; ai < 2; ++ai) {
                u32x4 g[4][2];
#pragma unroll
                for (int m = 0; m < 4; ++m)
#pragma unroll
                    for (int bj = 0; bj < 2; ++bj) g[m][bj] = *(const u32x4*)(gates + (size_t)EPI_ROWS(ai, m) * 2048 + 1024 + EPI_COL(bj));
#pragma unroll
                for (int m = 0; m < 4; ++m)
#pragma unroll
                    for (int bj = 0; bj < 2; ++bj) { const u32x4 gg = g[m][bj];
                        f32x4 v0 = acc[ai][bj][m][0], v1 = acc[ai][bj][m][1];
                        v0[0] *= bflo(gg.x); v0[1] *= bfhi(gg.x); v0[2] *= bflo(gg.y); v0[3] *= bfhi(gg.y);
                        v1[0] *= bflo(gg.z); v1[1] *= bfhi(gg.z); v1[2] *= bflo(gg.w); v1[3] *= bfhi(gg.w);
                        store8(U + (size_t)EPI_ROWS(ai, m) * 1024 + EPI_COL(bj), v0, v1); }
                asm volatile("" ::: "memory");
            }
        }
    }
};
template <bool BASE_BF16> struct EpiResid {
    static constexpr bool PERM = true, AFTER_DRAIN = false, DUAL = false;
    const float* base_p; const float* base_s;
    const bf16_t* base_b; bf16_t* XB; float* rowsq;
    __device__ __forceinline__ void operator()(const Acc& acc, const pg8::Unit& u, int wr, int wc, int fr, int fq) const {
#pragma unroll
        for (int ai = 0; ai < 2; ++ai) { float ssv[4];
#pragma unroll
            for (int mp = 0; mp < 2; ++mp) {
                f32x4 b[2][2][2];
#pragma unroll
                for (int mm = 0; mm < 2; ++mm) { const int row = EPI_ROWS(ai, 2 * mp + mm);
                    if (BASE_BF16) {
#pragma unroll
                        for (int bj = 0; bj < 2; ++bj) { const u32x4 t = *(const u32x4*)(base_b + (size_t)row * 1024 + EPI_COL(bj));
                            b[mm][bj][0] = (f32x4){bflo(t.x), bfhi(t.x), bflo(t.y), bfhi(t.y)}; b[mm][bj][1] = (f32x4){bflo(t.z), bfhi(t.z), bflo(t.w), bfhi(t.w)}; }
                    } else {
                        const float* brow = row < MP ? base_p + (size_t)row * 1024 : base_s + (size_t)(row - MP) * 1024;
#pragma unroll
                        for (int bj = 0; bj < 2; ++bj) { b[mm][bj][0] = *(const f32x4*)(brow + EPI_COL(bj)); b[mm][bj][1] = *(const f32x4*)(brow + EPI_COL(bj) + 4); }
                    } }
#pragma unroll
                for (int mm = 0; mm < 2; ++mm) { const int m = 2 * mp + mm, row = EPI_ROWS(ai, m); float ss = 0.f;
#pragma unroll
                    for (int bj = 0; bj < 2; ++bj) { const int col = EPI_COL(bj);
                        const f32x4 v0 = acc[ai][bj][m][0] + b[mm][bj][0], v1 = acc[ai][bj][m][1] + b[mm][bj][1];
                        store8(XB + (size_t)row * 1024 + col, v0, v1);
                        ss += (v0[0] * v0[0] + v0[1] * v0[1]) + (v0[2] * v0[2] + v0[3] * v0[3]) + (v1[0] * v1[0] + v1[1] * v1[1]) + (v1[2] * v1[2] + v1[3] * v1[3]); }
                    ss += __shfl_xor(ss, 16); ss += __shfl_xor(ss, 32);
                    ssv[m] = ss; }
                asm volatile("" ::: "memory");
            }
            rowsum_atomic4(rowsq, ssv, EPI_ROWS(ai, 0), fq); }
    }
};
struct EpiGLU {
    static constexpr bool PERM = true, AFTER_DRAIN = false, DUAL = false;
    bf16_t* H; const float* rowsq;
    __device__ __forceinline__ void operator()(const Acc& acc, const pg8::Unit& u, int wr, int wc, int fr, int fq) const {
        float rq[2][4];
#pragma unroll
        for (int ai = 0; ai < 2; ++ai)
#pragma unroll
            for (int m = 0; m < 4; ++m) rq[ai][m] = rowsq[EPI_ROWS(ai, m)];
#pragma unroll
        for (int ai = 0; ai < 2; ++ai)
#pragma unroll
            for (int m = 0; m < 4; ++m) {
                const int row = EPI_ROWS(ai, m);
                const float rstd = __builtin_amdgcn_rsqf(rq[ai][m] * (1.0f / 1024.0f) + EPSN);
#pragma unroll
                for (int bj = 0; bj < 2; ++bj) {
                    const int hc = u.pn * 128 + bj * 64 + wc * 16 + 4 * fq;
                    const f32x4 g = acc[ai][bj][m][0] * rstd, up = acc[ai][bj][m][1] * rstd;
                    float h[4];
#pragma unroll
                    for (int e = 0; e < 4; ++e) h[e] = g[e] * sigmoidf_(g[e]) * up[e];
                    u32x2 w; w.x = pk2(h[0], h[1]); w.y = pk2(h[2], h[3]);
                    *(u32x2*)(H + (size_t)row * DFF + hc) = w;
                }
            }
    }
};
struct EpiPle {
    static constexpr bool PERM = true, AFTER_DRAIN = false, DUAL = false;
    const bf16_t* X2B; bf16_t* X3B; const bf16_t* PW; const float* rowsq2; float* rowsq3;
    __device__ __forceinline__ void operator()(const Acc& acc, const pg8::Unit& u, int wr, int wc, int fr, int fq) const {
        float rq[2][4];
#pragma unroll
        for (int ai = 0; ai < 2; ++ai)
#pragma unroll
            for (int m = 0; m < 4; ++m) rq[ai][m] = rowsq2[EPI_ROWS(ai, m)];
#pragma unroll
        for (int ai = 0; ai < 2; ++ai) { float ssv[4];
#pragma unroll
            for (int mp = 0; mp < 2; ++mp) {
                u32x4 xb[2][2], t[2][2];
#pragma unroll
                for (int mm = 0; mm < 2; ++mm)
#pragma unroll
                    for (int bj = 0; bj < 2; ++bj) { const size_t off = (size_t)EPI_ROWS(ai, 2 * mp + mm) * 1024 + EPI_COL(bj);
                        xb[mm][bj] = *(const u32x4*)(X2B + off); t[mm][bj] = *(const u32x4*)(PW + off); }
#pragma unroll
                for (int mm = 0; mm < 2; ++mm) { const int m = 2 * mp + mm, row = EPI_ROWS(ai, m);
                    const float rstd = __builtin_amdgcn_rsqf(rq[ai][m] * (1.0f / 1024.0f) + EPSN); float ss = 0.f;
#pragma unroll
                    for (int bj = 0; bj < 2; ++bj) {
                        const u32x4 bb = xb[mm][bj], tt = t[mm][bj];
                        const f32x4 a0 = acc[ai][bj][m][0] * rstd, a1 = acc[ai][bj][m][1] * rstd;
                        f32x4 v0, v1;
                        v0[0] = bflo(bb.x) + sigmoidf_(a0[0]) * bflo(tt.x); v0[1] = bfhi(bb.x) + sigmoidf_(a0[1]) * bfhi(tt.x); v0[2] = bflo(bb.y) + sigmoidf_(a0[2]) * bflo(tt.y); v0[3] = bfhi(bb.y) + sigmoidf_(a0[3]) * bfhi(tt.y);
                        v1[0] = bflo(bb.z) + sigmoidf_(a1[0]) * bflo(tt.z); v1[1] = bfhi(bb.z) + sigmoidf_(a1[1]) * bfhi(tt.z); v1[2] = bflo(bb.w) + sigmoidf_(a1[2]) * bflo(tt.w); v1[3] = bfhi(bb.w) + sigmoidf_(a1[3]) * bfhi(tt.w);
                        store8(X3B + (size_t)row * 1024 + EPI_COL(bj), v0, v1);
                        ss += (v0[0] * v0[0] + v0[1] * v0[1]) + (v0[2] * v0[2] + v0[3] * v0[3]) + (v1[0] * v1[0] + v1[1] * v1[1]) + (v1[2] * v1[2] + v1[3] * v1[3]); }
                    ss += __shfl_xor(ss, 16); ss += __shfl_xor(ss, 32);
                    ssv[m] = ss; }
                asm volatile("" ::: "memory");
            }
            rowsum_atomic4(rowsq3, ssv, EPI_ROWS(ai, 0), fq); }
    }
};

constexpr int A_K0 = 0, A_KB = 13312, A_V0 = 4 * A_KB, A_VB = 9216, A_TBL = A_V0 + 4 * A_VB + 1024;
static_assert(A_TBL + 465 * 4 < 131072, "attention LDS");

__device__ __forceinline__ float max3f(float a, float b, float c) { float r; asm("v_max3_f32 %0, %1, %2, %3" : "=v"(r) : "v"(a), "v"(b), "v"(c)); return r; }
__device__ __forceinline__ float rowmax32(const f32x16& p0, const f32x16& p1) {
    float a = max3f(p0[0], p0[1], p1[0]), b = max3f(p0[2], p0[3], p1[1]); a = max3f(a, p1[2], p1[3]);
#pragma unroll
    for (int r = 4; r < 16; r += 4) { a = max3f(a, p0[r], p0[r + 1]); b = max3f(b, p0[r + 2], p0[r + 3]); a = max3f(a, p1[r], p1[r + 1]); b = max3f(b, p1[r + 2], p1[r + 3]); }
    const float m = fmaxf(a, b);
    auto rr = __builtin_amdgcn_permlane32_swap(__float_as_uint(m), __float_as_uint(m), false, false);
    return fmaxf(__uint_as_float(rr[0]), __uint_as_float(rr[1]));
}
__device__ __forceinline__ void glds16(const void* gsrc, unsigned lds_dst) { unsigned keep;
    asm volatile("s_mov_b32 %0, m0\n\ts_mov_b32 m0, %2\n\ts_nop 0\n\tglobal_load_lds_dwordx4 %1, off\n\ts_mov_b32 m0, %0" : "=&s"(keep) : "v"(gsrc), "s"(lds_dst) : "memory"); }
template <int LO, int HI> __device__ __forceinline__ void g_exp(f32x16& X) {
#pragma unroll
    for (int r = LO; r < HI; ++r) X[r] = __builtin_amdgcn_exp2f(X[r]);
}
template <int LO, int HI> __device__ __forceinline__ void g_sumpk(const f32x16& X, float& psa, float& psb, u32x4& pwlo, u32x4& pwhi) {
#pragma unroll
    for (int r = LO; r < HI; r += 2) { psa += X[r]; psb += X[r + 1]; const unsigned w = pk2(X[r], X[r + 1]); if (r < 8) pwlo[(r >> 1) & 3] = w; else pwhi[(r >> 1) & 3] = w; }
    asm volatile("" : "+v"(psa), "+v"(psb));
}
constexpr float A_THR = 8.0f;

template <bool NA>
__device__ __forceinline__ void attn_unit(LAS unsigned char* lds, const bf16_t* Q, const bf16_t* Kg, const bf16_t* Kr, const bf16_t* Vt, bf16_t* O,
                                          int h, int seqrow0, int q0, int t0, int NT, int rows, int g0, const float* rpb_h, int wid) {
    constexpr int DQK = NA ? 64 : 96, NJ = DQK / 16, KP = DQK + 8, QPITCH = NA ? 512 : 768;
    const int lane = my_lane(), tid = wid * 64 + lane, r32 = lane & 31, hi = lane >> 5;
    const int kvr = tid >> 3, c8 = tid & 7;
    const bf16_t* ksrc = Kg + (size_t)(seqrow0 + t0 * 64 + kvr) * 512 + h * 64 + 8 * c8;
    const bf16_t* rsrc = NA ? nullptr : Kr + (size_t)(seqrow0 + t0 * 64 + (tid >> 2)) * 32 + 8 * (tid & 3);
    const bf16_t* vsrc = Vt + (size_t)(h * 64 + kvr) * MT + seqrow0 + t0 * 64 + 8 * c8;
    const unsigned kdst = A_K0 + (kvr * KP + 8 * c8) * 2, rdst = A_K0 + ((tid >> 2) * KP + 64 + 8 * (tid & 3)) * 2, vdst = A_V0 + (kvr * 72 + 16 * (c8 >> 1) + 4 * (c8 & 1)) * 2;
    u32x4 rk, rr, rv;
#define A_LOADK(t) do { const int tt_ = (t) < NT ? (t) : NT - 1; const size_t ro = (size_t)(tt_ * 64); rk = *(const u32x4*)(ksrc + ro * 512); if (!NA && tid < 256) rr = *(const u32x4*)(rsrc + ro * 32); } while (0)
#define A_LOADV(t) do { const int tt_ = (t) < NT ? (t) : NT - 1; rv = *(const u32x4*)(vsrc + (size_t)(tt_ * 64)); } while (0)
#define A_STOREK(b) do { *(LAS u32x4*)(lds + kdst + (b) * A_KB) = rk; if (!NA && tid < 256) *(LAS u32x4*)(lds + rdst + (b) * A_KB) = rr; } while (0)
#define A_STOREV(b) do { *(LAS u32x2*)(lds + vdst + (b) * A_VB) = (u32x2){rv.x, rv.y}; *(LAS u32x2*)(lds + vdst + (b) * A_VB + 16) = (u32x2){rv.z, rv.w}; } while (0)
    int g = 0, rs = 0, c = 0, cs = 0;
    if (NA) {
        g = g0 + (wid >> 1); rs = g - 4; rs = rs < 0 ? 0 : (rs > rows - 8 ? rows - 8 : rs);
        c = 32 * (wid & 1) + r32; cs = c - 8; cs = cs < 0 ? 0 : (cs > 48 ? 48 : cs);
        LAS float* tbl = (LAS float*)(lds + A_TBL);
        if (tid < 465) tbl[tid] = rpb_h[tid] * LOG2E;
    }
    const unsigned lds_u = (unsigned)(uintptr_t)lds;
    const char* dk_src[2] = {nullptr, nullptr}; unsigned dk_str[2] = {0u, 0u}; const char* dv_src[2] = {nullptr, nullptr};
    {
        constexpr int CPR = NA ? 9 : 13;
#pragma unroll
        for (int j = 0; j < 2; ++j) { const int ci = 64 * (wid + 8 * j) + lane, row = (ci / CPR) & 63, col = ci % CPR;
            const bool rope = !NA && (col >= 8 && col < 12);
            dk_src[j] = rope ? (const char*)(Kr + (size_t)(seqrow0 + t0 * 64 + row) * 32 + 8 * (col - 8)) : (const char*)(Kg + (size_t)(seqrow0 + t0 * 64 + row) * 512 + h * 64 + 8 * (col & 7));
            dk_str[j] = rope ? 64u * 64u : 64u * 1024u; }
#pragma unroll
        for (int j = 0; j < 2; ++j) { const int ci = 64 * (wid + 8 * j) + lane, row = ci / 9, col = ci - 9 * row;
            dv_src[j] = (const char*)(Vt + (size_t)(h * 64 + (row & 63)) * MT + seqrow0 + t0 * 64 + 8 * (col & 7)); }
    }
#define A_DMAK(t, slot) do { const unsigned tt_ = (unsigned)((t) < NT ? (t) : NT - 1); \
        glds16(dk_src[0] + (size_t)tt_ * dk_str[0], (unsigned)__builtin_amdgcn_readfirstlane(lds_u + A_K0 + (slot) * A_KB + wid * 1024)); \
        if (NA ? wid == 0 : wid < 5) glds16(dk_src[1] + (size_t)tt_ * dk_str[1], (unsigned)__builtin_amdgcn_readfirstlane(lds_u + A_K0 + (slot) * A_KB + (wid + 8) * 1024)); } while (0)
#define A_DMAV(t, slot) do { const unsigned tt_ = (unsigned)((t) < NT ? (t) : NT - 1); \
        glds16(dv_src[0] + (size_t)tt_ * 128u, (unsigned)__builtin_amdgcn_readfirstlane(lds_u + A_V0 + (slot) * A_VB + wid * 1024)); \
        if (wid == 0) glds16(dv_src[1] + (size_t)tt_ * 128u, (unsigned)__builtin_amdgcn_readfirstlane(lds_u + A_V0 + (slot) * A_VB + 8 * 1024)); } while (0)
    const size_t qrow = (size_t)(seqrow0 + q0 + wid * 32 + r32);
    bf16x8 qr[NJ];
#pragma unroll
    for (int j = 0; j < NJ; ++j) qr[j] = *(const bf16x8*)(Q + qrow * QPITCH + h * DQK + 16 * j + 8 * hi);
    f32x16 o0, o1, negm;
#pragma unroll
    for (int r = 0; r < 16; ++r) { o0[r] = 0.f; o1[r] = 0.f; negm[r] = 0.f; }
    float mref = 0.f, lrun = 0.f;
    const LAS unsigned char* kfb = lds + A_K0 + (r32 * KP + 8 * hi) * 2;
    const LAS unsigned char* vfb = lds + A_V0 + (r32 * 72 + 8 * hi) * 2;
#define A_QK(N0, N1, b) do { const LAS unsigned char* kp_ = kfb + (b) * A_KB; \
        _Pragma("unroll") for (int j = 0; j < NJ; ++j) { \
            const bf16x8 a0_ = *(const LAS bf16x8*)(kp_ + j * 32), a1_ = *(const LAS bf16x8*)(kp_ + 32 * KP * 2 + j * 32); \
            N0 = __builtin_amdgcn_mfma_f32_32x32x16_bf16(a0_, qr[j], j == 0 ? negm : N0, 0, 0, 0); \
            N1 = __builtin_amdgcn_mfma_f32_32x32x16_bf16(a1_, qr[j], j == 0 ? negm : N1, 0, 0, 0); } } while (0)
#define A_MASK(N0, N1, t) do { if (NA) { const int kr_ = t0 + (t); const bool act_ = (kr_ >= rs) && (kr_ < rs + 8) && ((t) < NT); \
        const LAS float* tb_ = (const LAS float*)(lds + A_TBL) + ((act_ ? kr_ - g + 7 : 0) * 31 + 15 - c + 4 * hi); const int kb_ = act_ ? 4 * hi - cs : -1000; \
        _Pragma("unroll") for (int r = 0; r < 16; ++r) { const int kc0 = (r & 3) + 8 * (r >> 2), kc1 = kc0 + 32; const float b0_ = tb_[kc0], b1_ = tb_[kc1]; \
            N0[r] = ((unsigned)(kb_ + kc0) < 16u) ? N0[r] + b0_ : -INFINITY; N1[r] = ((unsigned)(kb_ + kc1) < 16u) ? N1[r] + b1_ : -INFINITY; } } } while (0)
#define A_SB() __builtin_amdgcn_sched_barrier(0)
#define A_QKG(N0, N1, j) do { bf16x8 kn0_ = kf0_, kn1_ = kf1_; \
        if ((j) + 1 < NJ) { kn0_ = *(const LAS bf16x8*)(kp_ + ((j) + 1) * 32); kn1_ = *(const LAS bf16x8*)(kp_ + 32 * KP * 2 + ((j) + 1) * 32); } \
        else { kn0_ = *(const LAS bf16x8*)(vp_); kn1_ = *(const LAS bf16x8*)(vp_ + 32 * 144); } \
        N0 = __builtin_amdgcn_mfma_f32_32x32x16_bf16(kf0_, qr[j], (j) == 0 ? negm : N0, 0, 0, 0); \
        N1 = __builtin_amdgcn_mfma_f32_32x32x16_bf16(kf1_, qr[j], (j) == 0 ? negm : N1, 0, 0, 0); \
        kf0_ = kn0_; kf1_ = kn1_; } while (0)
#define A_PVG(blk) do { bf16x8 kn0_ = kf0_, kn1_ = kf1_; \
        if ((blk) + 1 < 4) { kn0_ = *(const LAS bf16x8*)(vp_ + ((blk) + 1) * 32); kn1_ = *(const LAS bf16x8*)(vp_ + 32 * 144 + ((blk) + 1) * 32); } \
        const bf16x8 pb_ = __builtin_bit_cast(bf16x8, pw_[blk]); \
        o0 = __builtin_amdgcn_mfma_f32_32x32x16_bf16(kf0_, pb_, o0, 0, 0, 0); \
        o1 = __builtin_amdgcn_mfma_f32_32x32x16_bf16(kf1_, pb_, o1, 0, 0, 0); \
        kf0_ = kn0_; kf1_ = kn1_; } while (0)
#define A_STEP(C0, C1, TMC, N0, N1, TMN, t) do { \
        const LAS unsigned char* kp_ = kfb + (((t) + 1) & 3) * A_KB; const LAS unsigned char* vp_ = vfb + ((t) & 3) * A_VB; \
        bf16x8 kf0_ = *(const LAS bf16x8*)(kp_), kf1_ = *(const LAS bf16x8*)(kp_ + 32 * KP * 2); \
        { const bool first_ = NA ? (t0 + (t) == rs) : ((t) == 0); \
          if (first_ || __any(TMC > A_THR)) { const float dl_ = first_ ? (TMC > -1e20f ? TMC : 0.f) : fmaxf(TMC, 0.f); mref += dl_; const float f_ = __builtin_amdgcn_exp2f(-dl_); lrun *= f_; \
              _Pragma("unroll") for (int r = 0; r < 16; ++r) { o0[r] *= f_; o1[r] *= f_; C0[r] -= dl_; C1[r] -= dl_; negm[r] = -mref; } } } \
        A_DMAK((t) + 3, ((t) + 3) & 3); A_DMAV((t) + 2, ((t) + 2) & 3); \
        u32x4 pw_[4]; float psa_ = 0.f, psb_ = 0.f; \
        A_SB(); \
        if constexpr (!NA) { \
            A_QKG(N0, N1, 0); g_exp<0, 6>(C0); A_SB(); \
            A_QKG(N0, N1, 1); g_exp<6, 12>(C0); g_sumpk<0, 6>(C0, psa_, psb_, pw_[0], pw_[1]); A_SB(); \
            A_QKG(N0, N1, 2); g_exp<12, 16>(C0); g_sumpk<6, 12>(C0, psa_, psb_, pw_[0], pw_[1]); A_SB(); \
            A_QKG(N0, N1, 3); g_exp<0, 6>(C1); g_sumpk<12, 16>(C0, psa_, psb_, pw_[0], pw_[1]); A_SB(); \
            A_QKG(N0, N1, 4); g_exp<6, 12>(C1); g_sumpk<0, 6>(C1, psa_, psb_, pw_[2], pw_[3]); A_SB(); \
            A_QKG(N0, N1, 5); g_exp<12, 16>(C1); g_sumpk<6, 12>(C1, psa_, psb_, pw_[2], pw_[3]); A_SB(); \
            A_PVG(0); g_sumpk<12, 16>(C1, psa_, psb_, pw_[2], pw_[3]); A_SB(); \
        } else { \
            A_QKG(N0, N1, 0); g_exp<0, 8>(C0); A_SB(); \
            A_QKG(N0, N1, 1); g_exp<8, 16>(C0); g_sumpk<0, 8>(C0, psa_, psb_, pw_[0], pw_[1]); A_SB(); \
            A_QKG(N0, N1, 2); g_exp<0, 8>(C1); g_sumpk<8, 16>(C0, psa_, psb_, pw_[0], pw_[1]); A_SB(); \
            A_QKG(N0, N1, 3); g_exp<8, 16>(C1); g_sumpk<0, 8>(C1, psa_, psb_, pw_[2], pw_[3]); A_SB(); \
            A_PVG(0); g_sumpk<8, 16>(C1, psa_, psb_, pw_[2], pw_[3]); A_SB(); \
        } \
        A_PVG(1); A_MASK(N0, N1, (t) + 1); A_SB(); \
        A_PVG(2); TMN = rowmax32(N0, N1); A_SB(); \
        A_PVG(3); lrun += psa_ + psb_; asm volatile("" :: "v"(negm));     \
        A_SB(); \
        if ((t) & 1) { asm volatile("s_waitcnt vmcnt(0)" ::: "memory"); __syncthreads(); } } while (0)

#define A_STEP_NA(C0, C1, TMC, N0, N1, TMN, t) do { \
        const int krc_ = t0 + (t); const bool actc_ = (krc_ >= rs) && (krc_ < rs + 8), actn_ = (krc_ + 1 >= rs) && (krc_ + 1 < rs + 8) && ((t) + 1 < NT); \
        A_DMAK((t) + 3, ((t) + 3) & 3); A_DMAV((t) + 2, ((t) + 2) & 3); \
        if (actc_) { const bool first_ = (krc_ == rs); \
          if (first_ || __any(TMC > A_THR)) { const float dl_ = first_ ? TMC : fmaxf(TMC, 0.f); mref += dl_; const float f_ = __builtin_amdgcn_exp2f(-dl_); lrun *= f_; \
              _Pragma("unroll") for (int r = 0; r < 16; ++r) { o0[r] *= f_; o1[r] *= f_; C0[r] -= dl_; C1[r] -= dl_; negm[r] = -mref; } } } \
        if (actn_) { A_QK(N0, N1, ((t) + 1) & 3); A_MASK(N0, N1, (t) + 1); TMN = rowmax32(N0, N1); } \
        if (actc_) { float ps_ = 0.f; \
            _Pragma("unroll") for (int r = 0; r < 16; ++r) { C0[r] = __builtin_amdgcn_exp2f(C0[r]); C1[r] = __builtin_amdgcn_exp2f(C1[r]); ps_ += C0[r] + C1[r]; } \
            lrun += ps_; \
            u32x4 pw_[4]; \
            pw_[0] = (u32x4){pk2(C0[0], C0[1]), pk2(C0[2], C0[3]), pk2(C0[4], C0[5]), pk2(C0[6], C0[7])}; \
            pw_[1] = (u32x4){pk2(C0[8], C0[9]), pk2(C0[10], C0[11]), pk2(C0[12], C0[13]), pk2(C0[14], C0[15])}; \
            pw_[2] = (u32x4){pk2(C1[0], C1[1]), pk2(C1[2], C1[3]), pk2(C1[4], C1[5]), pk2(C1[6], C1[7])}; \
            pw_[3] = (u32x4){pk2(C1[8], C1[9]), pk2(C1[10], C1[11]), pk2(C1[12], C1[13]), pk2(C1[14], C1[15])}; \
            const LAS unsigned char* vp_ = vfb + ((t) & 3) * A_VB; \
            _Pragma("unroll") for (int blk = 0; blk < 4; ++blk) { \
                const bf16x8 va0 = *(const LAS bf16x8*)(vp_ + blk * 32), va1 = *(const LAS bf16x8*)(vp_ + 32 * 144 + blk * 32); \
                const bf16x8 pb_ = __builtin_bit_cast(bf16x8, pw_[blk]); \
                o0 = __builtin_amdgcn_mfma_f32_32x32x16_bf16(va0, pb_, o0, 0, 0, 0); \
                o1 = __builtin_amdgcn_mfma_f32_32x32x16_bf16(va1, pb_, o1, 0, 0, 0); } } \
        if ((t) & 1) { asm volatile("s_waitcnt vmcnt(0)" ::: "memory"); __syncthreads(); } } while (0)

    { A_DMAK(0, 0); A_DMAV(0, 0); A_DMAK(1, 1); A_DMAK(2, 2); A_DMAV(1, 1); }
    asm volatile("s_waitcnt vmcnt(0)" ::: "memory");
    __syncthreads();
    f32x16 sA0, sA1, sB0, sB1; float tmA, tmB;
    A_QK(sA0, sA1, 0);
    A_MASK(sA0, sA1, 0);
    tmA = rowmax32(sA0, sA1);
    __syncthreads();
    if constexpr (NA) {
        for (int t = 0; t < NT; t += 2) {
            A_STEP_NA(sA0, sA1, tmA, sB0, sB1, tmB, t);
            if (t + 1 < NT) A_STEP_NA(sB0, sB1, tmB, sA0, sA1, tmA, t + 1);
        }
        if (NT & 1) { asm volatile("s_waitcnt vmcnt(0)" ::: "memory"); __syncthreads(); }
    } else {
        for (int t = 0; t < NT; t += 2) {
            A_STEP(sA0, sA1, tmA, sB0, sB1, tmB, t);
            A_STEP(sB0, sB1, tmB, sA0, sA1, tmA, t + 1);
        }
    }
    const float lt = lrun + __shfl_xor(lrun, 32);
    const float inv = 1.0f / lt;
    bf16_t* orow = O + qrow * 512 + h * 64 + 4 * hi;
#pragma unroll
    for (int gq = 0; gq < 4; ++gq) {
        u32x2 w0, w1;
        w0.x = pk2(o0[4 * gq] * inv, o0[4 * gq + 1] * inv); w0.y = pk2(o0[4 * gq + 2] * inv, o0[4 * gq + 3] * inv);
        w1.x = pk2(o1[4 * gq] * inv, o1[4 * gq + 1] * inv); w1.y = pk2(o1[4 * gq + 2] * inv, o1[4 * gq + 3] * inv);
        *(u32x2*)(orow + 8 * gq) = w0; *(u32x2*)(orow + 32 + 8 * gq) = w1;
    }
#undef A_LOADK
#undef A_LOADV
#undef A_STOREK
#undef A_STOREV
#undef A_QK
#undef A_MASK
#undef A_STEP
#undef A_DMAK
#undef A_DMAV
#undef A_STEP_NA
#undef A_SB
#undef A_QKG
#undef A_PVG
}

template <class Map>
__device__ __forceinline__ void transpose_item(const float* W, int ldw, int K, int N, bf16_t* WT, const float* gain, LAS float* scr, int item, int lane, Map map) {
    const int nblk = N / 32, kb = item / nblk, nb = item % nblk, k0 = 64 * kb, n0 = 32 * nb;
    const int src = map(n0 + (lane & 31));
#pragma unroll 8
    for (int i = 0; i < 32; ++i) { const int kk = 2 * i + (lane >> 5); float v = 0.f; if (src >= 0) { v = W[(size_t)(k0 + kk) * ldw + src]; if (gain) v *= gain[k0 + kk]; } scr[kk * 33 + (lane & 31)] = v; }
    asm volatile("s_waitcnt lgkmcnt(0)" ::: "memory");
    const int c = lane & 7;
#pragma unroll
    for (int j = 0; j < 4; ++j) { const int n = (lane >> 3) + 8 * j; const LAS float* s = scr + (8 * c) * 33 + n;
        u32x4 o; o.x = pk2(s[0 * 33], s[1 * 33]); o.y = pk2(s[2 * 33], s[3 * 33]); o.z = pk2(s[4 * 33], s[5 * 33]); o.w = pk2(s[6 * 33], s[7 * 33]);
        *(u32x4*)(WT + (size_t)(n0 + n) * K + k0 + 8 * c) = o; }
    asm volatile("s_waitcnt lgkmcnt(0)" ::: "memory");
}
__device__ __forceinline__ float2 rope_cs(int pos, int i) {
    const int a = i & 3, b = i >> 2;
    const double cf = a == 0 ? 1.0 : a == 1 ? 0.5623413251903491 : a == 2 ? 0.31622776601683794 : 0.1778279410038923;
    const double sf = b == 0 ? 1.0 : b == 1 ? 0.1 : b == 2 ? 0.01 : 0.001;
    double rev = (double)pos * (cf * sf) * 0.15915494309189535;
    rev -= __builtin_floor(rev);
    const float fr = (float)rev;
    return make_float2(__builtin_amdgcn_cosf(fr), __builtin_amdgcn_sinf(fr));
}
__device__ __forceinline__ int rope_perm(int p) { return 16 * ((p >> 2) & 1) + 4 * (p >> 3) + (p & 3); }

#define XB_TMO      128
#define XB_XCNT(j)  (256  + 64 * (j))
#define XB_XSUB(j)  (1280 + 64 * (j))
#define XB_XGEN(j)  (2304 + 64 * (j))
#define XB_TOP      3328
#define XB_TOPGEN   3392
#define XCD_BAR_WORDS 3456
#define XB_SPIN_CAP (1u << 18)

__device__ __forceinline__ unsigned xb_ld(unsigned* p)              { return __hip_atomic_load(p, __ATOMIC_RELAXED, __HIP_MEMORY_SCOPE_AGENT); }
__device__ __forceinline__ unsigned xb_add(unsigned* p, unsigned v) { return __hip_atomic_fetch_add(p, v, __ATOMIC_RELAXED, __HIP_MEMORY_SCOPE_AGENT); }
__device__ __forceinline__ unsigned xb_xcc_id() { return (unsigned)__builtin_amdgcn_s_getreg((3 << 11) | 20) & 0xFu; }
#define XB_SPIN(cond, bar) do { unsigned _sp = 0; while (cond) { __builtin_amdgcn_s_sleep(1); \
    if ((++_sp & 255u) == 0u) { if (xb_ld(&(bar)[XB_TMO])) break; if (_sp > XB_SPIN_CAP) { atomicAdd(&(bar)[XB_TMO], 1u); break; } } } } while (0)

struct XcdBarrier {
    unsigned* bar; unsigned x;
    volatile LAS unsigned* st;
};

__device__ __forceinline__ XcdBarrier xcd_barrier_post(unsigned* bar, volatile LAS unsigned* st) {
    XcdBarrier b; b.bar = bar; b.x = xb_xcc_id(); b.st = st;
    if (threadIdx.x == 0) (void)xb_add(&bar[XB_XCNT(b.x)], 1u);
    return b;
}
__device__ __forceinline__ void xcd_barrier_complete(unsigned* bar, unsigned x, unsigned& nloc, unsigned& nx) {
    const unsigned G = gridDim.x * gridDim.y * gridDim.z;
    unsigned sum, cnt, mine, sp = 0u;
    for (;;) {
        sum = 0u; cnt = 0u; mine = 0u;
#pragma unroll
        for (unsigned j = 0; j < 16; ++j) { const unsigned c = xb_ld(&bar[XB_XCNT(j)]); sum += c; cnt += (c > 0u) ? 1u : 0u; mine = (j == x) ? c : mine; }
        if (sum == G) break;
        __builtin_amdgcn_s_sleep(1);
        if ((++sp & 255u) == 0u) { if (xb_ld(&bar[XB_TMO])) break; if (sp > XB_SPIN_CAP) { atomicAdd(&bar[XB_TMO], 1u); break; } }
    }
    nloc = mine > 0u ? mine : 1u; nx = cnt > 0u ? cnt : 1u;
}

__device__ __forceinline__ void xcd_barrier(const XcdBarrier& b) {
    asm volatile("s_waitcnt vmcnt(0)" ::: "memory");
    __syncthreads();
    if (threadIdx.x == 0) {
        unsigned* bar = b.bar;
        __builtin_amdgcn_s_waitcnt(0);
        unsigned nloc = b.st[0], nx = b.st[1];
        if (nloc == 0u) { xcd_barrier_complete(bar, b.x, nloc, nx); b.st[0] = nloc; b.st[1] = nx; }
        const unsigned old = xb_add(&bar[XB_XSUB(b.x)], 1u);
        const unsigned gen = old / nloc;
        if (old + 1u == (gen + 1u) * nloc) {
            __builtin_amdgcn_fence(__ATOMIC_RELEASE, "agent");
            asm volatile("s_waitcnt vmcnt(0)" ::: "memory");
            const unsigned og = xb_add(&bar[XB_TOP], 1u);
            const unsigned tg = og / nx;
            if (og + 1u == (tg + 1u) * nx) xb_add(&bar[XB_TOPGEN], 1u);
            else XB_SPIN(xb_ld(&bar[XB_TOPGEN]) == tg, bar);
            __builtin_amdgcn_fence(__ATOMIC_ACQUIRE, "agent");
            xb_add(&bar[XB_XGEN(b.x)], 1u);
            asm volatile("s_waitcnt vmcnt(0)" ::: "memory");
        } else {
            XB_SPIN(xb_ld(&bar[XB_XGEN(b.x)]) == gen, bar);
            __builtin_amdgcn_fence(__ATOMIC_ACQUIRE, "agent");
            asm volatile("s_waitcnt vmcnt(0)" ::: "memory");
        }
    }
    __syncthreads();
}

#define Wt_in ((bf16_t*)(kp->ws + W_IN))
#define Wt_vna ((bf16_t*)(kp->ws + W_VNA))
#define Wt_uq ((bf16_t*)(kp->ws + W_UQ))
#define Wt_uk ((bf16_t*)(kp->ws + W_UK))
#define Wt_uv ((bf16_t*)(kp->ws + W_UV))
#define Wt_nao ((bf16_t*)(kp->ws + W_NAO))
#define Wt_mlao ((bf16_t*)(kp->ws + W_MLAO))
#define Wt_out ((bf16_t*)(kp->ws + W_OUT))
#define Wt_gu ((bf16_t*)(kp->ws + W_GU))
#define Wt_dn ((bf16_t*)(kp->ws + W_DN))
#define Wt_pg ((bf16_t*)(kp->ws + W_PG))
#define Wt_pl ((bf16_t*)(kp->ws + W_PL))
#define ropetab ((float2*)(kp->ws + WS_ROPE))
#define rsq1 ((float*)(kp->ws + WS_RSQ))
#define krope ((bf16_t*)(kp->ws + WS_KROPE))
#define PB ((bf16_t*)(kp->ws + WS_PB))
#define XN ((bf16_t*)(kp->ws + WS_XN))
#define QNA ((bf16_t*)(kp->ws + WS_QNA))
#define KNA ((bf16_t*)(kp->ws + WS_KNA))
#define VTNA ((bf16_t*)(kp->ws + WS_VTNA))
#define ZLAT ((bf16_t*)(kp->ws + WS_ZLAT))
#define ZQN ((bf16_t*)(kp->ws + WS_ZQN))
#define ZKVN ((bf16_t*)(kp->ws + WS_ZKVN))
#define QM ((bf16_t*)(kp->ws + WS_QM))
#define KN ((bf16_t*)(kp->ws + WS_KN))
#define VTM ((bf16_t*)(kp->ws + WS_VTM))
#define MLAO ((bf16_t*)(kp->ws + WS_MLAO))
#define T1 ((bf16_t*)(kp->ws + WS_T1))
#define U ((bf16_t*)(kp->ws + WS_U))
#define XB1 ((bf16_t*)(kp->ws + WS_XB1))
#define HB ((bf16_t*)(kp->ws + WS_H))
#define XB2 ((bf16_t*)(kp->ws + WS_XB2))
#define PW ((bf16_t*)(kp->ws + WS_PW))
#define X3B ((bf16_t*)(kp->ws + 476 * MiB))
#define rsqQ (rsq1 + 3 * MT)
#define rsqKV (rsq1 + 4 * MT)
#define rsq2 (rsq1 + MT)
#define rsq3 (rsq1 + 2 * MT)
#define NAO QNA
#define GATES ((bf16_t*)kp->out)

typedef const __attribute__((address_space(4))) Params KParams;
__device__ __forceinline__ KParams* kparams() { unsigned long long p = (unsigned long long)__builtin_amdgcn_kernarg_segment_ptr(); asm volatile("" : "+s"(p)); return (KParams*)p; }
#define KP_RELOAD kp = kparams()
__global__ void __launch_bounds__(512, 2) fwd_kernel(Params P) {
    extern __shared__ __attribute__((aligned(16))) unsigned char lds_raw[];
    LAS unsigned char* lds = (LAS unsigned char*)lds_raw;
    cg::grid_group grid = cg::this_grid();
    const KParams* kp;
    KP_RELOAD;
    { volatile LAS unsigned* st0 = (volatile LAS unsigned*)(lds + LDS_BYTES - 64); if (threadIdx.x < 16) st0[threadIdx.x] = 0u; __syncthreads(); }
    const XcdBarrier xbar = xcd_barrier_post((unsigned*)(kp->ws + WS_CTL), (volatile LAS unsigned*)(lds + LDS_BYTES - 64));

    const int wave = __builtin_amdgcn_readfirstlane(threadIdx.x >> 6);
    const int G = gridDim.x, bx = blockIdx.x;
    const int vcu = (G % 8 == 0) ? (bx % 8) * (G / 8) + bx / 8 : bx;
    const int gw = vcu * 8 + wave, NGW = G * 8;
    KP_RELOAD;
    if constexpr (PHASES & 1) {
        const int lane = my_lane();
        LAS float* scr = (LAS float*)(lds + wave * 16384);
        constexpr int I_IN = 16 * (NIN / 32), I_VNA = 16 * 16, I_UQ = 6 * 24, I_UK = 4 * 16, I_UV = 4 * 16, I_NAO = 8 * 32, I_MLAO = 8 * 32, I_OUT = 16 * 32, I_GU = 16 * 176, I_DN = 44 * 32, I_PG = 16 * 32, I_PL = 4 * 32;
        constexpr int NITEMS = I_IN + I_VNA + I_UQ + I_UK + I_UV + I_NAO + I_MLAO + I_OUT + I_GU + I_DN + I_PG + I_PL;
        for (int it = gw; it < NITEMS; it += NGW) {
            int r = it;
            if (r < I_IN) { transpose_item(kp->w_in, 4256, 1024, NIN, Wt_in, nullptr, scr, r, lane, [](int n) { if (n < 1024) return n; if (n < 3072) return 2208 + (n - 1024); const int t = n - 3072; return t < 672 ? 1536 + t : -1; }); continue; } r -= I_IN;
            if (r < I_VNA) { transpose_item(kp->w_in, 4256, 1024, 512, Wt_vna, nullptr, scr, r, lane, [](int n) { return 1024 + n; }); continue; } r -= I_VNA;
            if (r < I_UQ) { transpose_item(kp->w_uq, 768, 384, 768, Wt_uq, kp->g_q, scr, r, lane, [](int n) { const int hh = n / 96, rr = n % 96; return rr < 64 ? n : hh * 96 + 64 + rope_perm(rr - 64); }); continue; } r -= I_UQ;
            if (r < I_UK) { transpose_item(kp->w_ukv, 1024, 256, 512, Wt_uk, kp->g_kv, scr, r, lane, [](int n) { return (n >> 6) * 128 + (n & 63); }); continue; } r -= I_UK;
            if (r < I_UV) { transpose_item(kp->w_ukv, 1024, 256, 512, Wt_uv, kp->g_kv, scr, r, lane, [](int n) { return (n >> 6) * 128 + 64 + (n & 63); }); continue; } r -= I_UV;
            if (r < I_NAO) { transpose_item(kp->w_nao, 1024, 512, 1024, Wt_nao, nullptr, scr, r, lane, [](int n) { return n; }); continue; } r -= I_NAO;
            if (r < I_MLAO) { transpose_item(kp->w_mlao, 1024, 512, 1024, Wt_mlao, nullptr, scr, r, lane, [](int n) { return n; }); continue; } r -= I_MLAO;
            if (r < I_OUT) { transpose_item(kp->w_out, 1024, 1024, 1024, Wt_out, nullptr, scr, r, lane, [](int n) { return n; }); continue; } r -= I_OUT;
            if (r < I_GU) { transpose_item(kp->w_gu, 5632, 1024, 5632, Wt_gu, kp->g_ffn, scr, r, lane, [](int n) { const int j = (n >> 3) * 4 + (n & 3); return ((n >> 2) & 1) ? DFF + j : j; }); continue; } r -= I_GU;
            if (r < I_DN) { transpose_item(kp->w_dn, 1024, 2816, 1024, Wt_dn, nullptr, scr, r, lane, [](int n) { return n; }); continue; } r -= I_DN;
            if (r < I_PG) { transpose_item(kp->w_pg, 1024, 1024, 1024, Wt_pg, kp->g_ple, scr, r, lane, [](int n) { return n; }); continue; } r -= I_PG;
            transpose_item(kp->w_pl, 1024, 256, 1024, Wt_pl, nullptr, scr, r, lane, [](int n) { return n; });
        }
        {
            f32x4 gmix[4];
#pragma unroll
            for (int j = 0; j < 4; ++j) gmix[j] = *(const f32x4*)(kp->g_mix + 4 * lane + 256 * j);
            for (int m0 = gw; m0 < MT; m0 += 4 * NGW) {
                f32x4 v[4][4], pv[4];
#pragma unroll
                for (int u = 0; u < 4; ++u) { const int m = m0 + u * NGW < MT ? m0 + u * NGW : m0;
                    const float* xr = m < MP ? kp->x_p + (size_t)m * 1024 : kp->x_s + (size_t)(m - MP) * 1024;
                    const float* pr = m < MP ? kp->p_p + (size_t)m * 256 : kp->p_s + (size_t)(m - MP) * 256;
#pragma unroll
                    for (int j = 0; j < 4; ++j) v[u][j] = *(const f32x4*)(xr + 4 * lane + 256 * j);
                    pv[u] = *(const f32x4*)(pr + 4 * lane); }
#pragma unroll
                for (int u = 0; u < 4; ++u) { const int m = m0 + u * NGW < MT ? m0 + u * NGW : m0; float s = 0.f;
#pragma unroll
                    for (int j = 0; j < 4; ++j) s += (v[u][j][0] * v[u][j][0] + v[u][j][1] * v[u][j][1]) + (v[u][j][2] * v[u][j][2] + v[u][j][3] * v[u][j][3]);
                    const float rstd = __builtin_amdgcn_rsqf(wave_sum(s) * (1.0f / 1024.0f) + EPSN);
#pragma unroll
                    for (int j = 0; j < 4; ++j) { const f32x4 gg = gmix[j]; u32x2 w; w.x = pk2(v[u][j][0] * rstd * gg[0], v[u][j][1] * rstd * gg[1]); w.y = pk2(v[u][j][2] * rstd * gg[2], v[u][j][3] * rstd * gg[3]);
                        *(u32x2*)(XN + (size_t)m * 1024 + 4 * lane + 256 * j) = w; }
                    u32x2 w; w.x = pk2(pv[u][0], pv[u][1]); w.y = pk2(pv[u][2], pv[u][3]);
                    *(u32x2*)(PB + (size_t)m * 256 + 4 * lane) = w; }
            }
        }
        for (int i = gw * 64 + lane; i < SS * 16; i += NGW * 64) ropetab[i] = rope_cs(i >> 4, i & 15);
        for (int i = gw * 64 + lane; i < 5 * MT; i += NGW * 64) rsq1[i] = 0.f;
    }
    if (kp->ws == nullptr) grid.sync();
    xcd_barrier(xbar);

    KP_RELOAD;
    if constexpr (PHASES & 2) {
        pg8::Gemm g{XN, Wt_in, MT, NIN, opq(1024)}; pg8::StaticOrder S; S.init(MT, NIN, G, bx);
        EpiIn E{QNA, KNA, GATES, ZLAT, rsqQ, rsqKV};
        pg8::gemm_phase<EpiIn, pg8::StaticOrder, true, true>(lds, g, S, E, wave * 64 + my_lane());
        pg8::Gemm g2{Wt_vna, XN, 512, MT, opq(1024)}; pg8::StaticOrder S2; S2.init(512, MT, G, bx);
        EpiPlainPermT E2{VTNA, MT};
        pg8::gemm_phase<EpiPlainPermT, pg8::StaticOrder, true, true>(lds, g2, S2, E2, wave * 64 + my_lane());
    }
    xcd_barrier(xbar);

    KP_RELOAD;
    if constexpr (PHASES & 8) {
        for (int i0 = gw * 64 + my_lane(); i0 < MT * 16; i0 += 4 * NGW * 64) {
            float x1[4], x2[4]; float2 cs[4];
#pragma unroll
            for (int u = 0; u < 4; ++u) { const int i = i0 + u * NGW * 64 < MT * 16 ? i0 + u * NGW * 64 : i0; const int m = i >> 4, ii = i & 15;
                const bf16_t* zr = ZLAT + (size_t)m * 768 + 640; x1[u] = bf2f(zr[ii]); x2[u] = bf2f(zr[16 + ii]); cs[u] = ropetab[(size_t)row_pos(m) * 16 + ii]; }
#pragma unroll
            for (int u = 0; u < 4; ++u) { const int i = i0 + u * NGW * 64 < MT * 16 ? i0 + u * NGW * 64 : i0; const int m = i >> 4, ii = i & 15;
                bf16_t* ko = krope + (size_t)m * 32 + 8 * (ii >> 2) + (ii & 3);
                ko[0] = (bf16_t)(pk2(x1[u] * cs[u].x - x2[u] * cs[u].y, 0.f) & 0xffffu); ko[4] = (bf16_t)(pk2(x2[u] * cs[u].x + x1[u] * cs[u].y, 0.f) & 0xffffu); }
        }
        pg8::Gemm g{ZLAT, Wt_uq, MT, 768, opq(384), 768, 0}; pg8::StaticOrder S; S.init(MT, 768, G, bx);
        EpiQRope E{QM, ropetab, rsqQ};
        pg8::gemm_phase<EpiQRope, pg8::StaticOrder, true, true>(lds, g, S, E, wave * 64 + my_lane());
        pg8::Gemm g2{ZLAT + 384, Wt_uk, MT, 512, opq(256), 768, 0}; pg8::StaticOrder S2; S2.init(MT, 512, G, bx);
        EpiRowScale E2{KN, 512, rsqKV, 1.0f / 256.0f};
        pg8::gemm_phase<EpiRowScale, pg8::StaticOrder, true, true>(lds, g2, S2, E2, wave * 64 + my_lane());
        pg8::Gemm g3{Wt_uv, ZLAT + 384, 512, MT, opq(256), 0, 768}; pg8::StaticOrder S3; S3.init(512, MT, G, bx);
        EpiColScale E3{VTM, MT, rsqKV, 1.0f / 256.0f};
        pg8::gemm_phase<EpiColScale, pg8::StaticOrder, true, true>(lds, g3, S3, E3, wave * 64 + my_lane());
    }
    xcd_barrier(xbar);

    KP_RELOAD;
    if constexpr (PHASES & 16) {
        for (int u = vcu; u < 3072; u += G) {
            int seqrow0, h, rg, rows;
            if (u < 2048) { seqrow0 = (u >> 8) * SP; h = (u >> 5) & 7; rg = u & 31; rows = 128; }
            else { const int v = u - 2048; seqrow0 = MP + (v >> 9) * SS; h = (v >> 6) & 7; rg = v & 63; rows = 256; }
            const int g0 = 4 * rg;
            int lo = g0 - 4; lo = lo < 0 ? 0 : (lo > rows - 8 ? rows - 8 : lo);
            int hi_ = g0 - 1; hi_ = hi_ < 0 ? 0 : (hi_ > rows - 8 ? rows - 8 : hi_); hi_ += 7;
            attn_unit<true>(lds, QNA, KNA, nullptr, VTNA, NAO, h, seqrow0, 256 * rg, lo, hi_ - lo + 1, rows, g0, kp->rpb + h * 465, wave);
        }
        for (int u = vcu; u < 2048; u += G) {
            const int pair = u >> 5, qb = u & 31;
            attn_unit<false>(lds, QM, KN, krope, VTM, MLAO, pair & 7, (pair >> 3) * SP, 256 * qb, 0, SP / 64, 0, 0, nullptr, wave);
        }
        for (int u = vcu; u < 1024; u += G) {
            const int pair = u >> 6, qb = u & 63;
            attn_unit<false>(lds, QM, KN, krope, VTM, MLAO, pair & 7, MP + (pair >> 3) * SS, 256 * qb, 0, SS / 64, 0, 0, nullptr, wave);
        }
    }
    xcd_barrier(xbar);

    KP_RELOAD;
    if constexpr (PHASES & 32) {
        pg8::Gemm g{NAO, Wt_nao, MT, 1024, opq(512), 0, 0, MLAO, Wt_mlao}; pg8::DualOrder S; S.b.init(MT, 1024, G, bx);
        EpiGateDual E{U, GATES};
        pg8::gemm_phase<EpiGateDual, pg8::DualOrder, true, true>(lds, g, S, E, wave * 64 + my_lane());
    }
    xcd_barrier(xbar);

    KP_RELOAD;
    if constexpr (PHASES & 64) {
        pg8::Gemm g{U, Wt_out, MT, 1024, opq(1024)}; pg8::StaticOrder S; S.init(MT, 1024, G, bx);
        EpiResid<false> E{kp->x_p, kp->x_s, nullptr, XB1, rsq1};
        pg8::gemm_phase<EpiResid<false>, pg8::StaticOrder, true, true>(lds, g, S, E, wave * 64 + my_lane());
    }
    xcd_barrier(xbar);

    KP_RELOAD;
    if constexpr (PHASES & 128) {
        pg8::Gemm g{XB1, Wt_gu, MT, 5632, opq(1024)}; pg8::StaticOrder S; S.init(MT, 5632, G, bx);
        EpiGLU E{HB, rsq1};
        pg8::gemm_phase<EpiGLU, pg8::StaticOrder, true, true>(lds, g, S, E, wave * 64 + my_lane());
    }
    xcd_barrier(xbar);

    KP_RELOAD;
    if constexpr (PHASES & 256) {
        pg8::Gemm g{HB, Wt_dn, MT, 1024, opq(DFF)}; pg8::StaticOrder S; S.init(MT, 1024, G, bx);
        EpiResid<true> E{nullptr, nullptr, XB1, XB2, rsq2};
        pg8::gemm_phase<EpiResid<true>, pg8::StaticOrder, true, true>(lds, g, S, E, wave * 64 + my_lane());
    }
    xcd_barrier(xbar);

    KP_RELOAD;
    if constexpr (PHASES & 512) {
        pg8::Gemm g{PB, Wt_pl, MT, 1024, opq(256)}; pg8::StaticOrder S; S.init(MT, 1024, G, bx);
        EpiPlain E{PW, 1024};
        pg8::gemm_phase<EpiPlain, pg8::StaticOrder, true, true>(lds, g, S, E, wave * 64 + my_lane());
        pg8::Gemm g2{XB2, Wt_pg, MT, 1024, opq(1024)};
        EpiPle E2{XB2, X3B, PW, rsq2, rsq3};
        pg8::gemm_phase<EpiPle, pg8::StaticOrder, true, true>(lds, g2, S, E2, wave * 64 + my_lane());
    }
    xcd_barrier(xbar);

    KP_RELOAD;
    if constexpr (PHASES & 1024) {
        const int lane = my_lane();
        f32x4 gfin[4];
#pragma unroll
        for (int j = 0; j < 4; ++j) gfin[j] = *(const f32x4*)(kp->g_fin + 4 * lane + 256 * j);
        for (int m0 = gw; m0 < MT; m0 += 4 * NGW) {
            u32x2 v[4][4]; float rq[4];
#pragma unroll
            for (int u = 0; u < 4; ++u) { const int m = m0 + u * NGW < MT ? m0 + u * NGW : m0; rq[u] = rsq3[m];
#pragma unroll
                for (int j = 0; j < 4; ++j) v[u][j] = *(const u32x2*)(X3B + (size_t)m * 1024 + 4 * lane + 256 * j); }
#pragma unroll
            for (int u = 0; u < 4; ++u) { const int m = m0 + u * NGW < MT ? m0 + u * NGW : m0; if (u > 0 && m == m0) continue; const float rstd = __builtin_amdgcn_rsqf(rq[u] * (1.0f / 1024.0f) + EPSN);
#pragma unroll
                for (int j = 0; j < 4; ++j) { const f32x4 x = (f32x4){bflo(v[u][j].x), bfhi(v[u][j].x), bflo(v[u][j].y), bfhi(v[u][j].y)};
                    *(f32x4*)(kp->out + (size_t)m * 1024 + 4 * lane + 256 * j) = x * rstd * gfin[j]; } }
        }
    }
}

#undef Wt_in
#undef Wt_vna
#undef Wt_uq
#undef Wt_uk
#undef Wt_uv
#undef Wt_nao
#undef Wt_mlao
#undef Wt_out
#undef Wt_gu
#undef Wt_dn
#undef Wt_pg
#undef Wt_pl
#undef ropetab
#undef rsq1
#undef krope
#undef PB
#undef XN
#undef QNA
#undef KNA
#undef VTNA
#undef ZLAT
#undef ZQN
#undef ZKVN
#undef QM
#undef KN
#undef VTM
#undef MLAO
#undef T1
#undef U
#undef XB1
#undef HB
#undef XB2
#undef PW
#undef X3B
#undef rsqQ
#undef rsqKV
#undef rsq2
#undef rsq3
#undef NAO
#undef GATES

extern "C" void kernel_launch(void* const* d_in, const int* in_sizes, int n_in, void* d_out, int out_size, void* d_ws, size_t ws_size, hipStream_t stream) {
    static int grid_blocks = 0;
    if (grid_blocks == 0) {
        if (n_in != 21 || out_size != MT * DM || ws_size < WS_NEED) { fprintf(stderr, "kernel_launch: unexpected shapes (n_in %d out %d ws %zu)\n", n_in, out_size, ws_size); grid_blocks = -1; return; }
        int dev = 0, cus = 0, per_cu = 0;
        hipGetDevice(&dev);
        hipDeviceGetAttribute(&cus, hipDeviceAttributeMultiprocessorCount, dev);
        hipFuncSetAttribute((const void*)fwd_kernel, hipFuncAttributeMaxDynamicSharedMemorySize, LDS_BYTES);
        hipOccupancyMaxActiveBlocksPerMultiprocessor(&per_cu, (const void*)fwd_kernel, 512, LDS_BYTES);
        if (per_cu < 1) per_cu = 1;
        grid_blocks = cus * 1;
        (void)hipGetLastError();
    }
    if (grid_blocks < 0) return;
    if (hipMemsetAsync((unsigned char*)d_ws + WS_CTL, 0, CTL_BYTES, stream) != hipSuccess) { fprintf(stderr, "kernel_launch: memset failed\n"); return; }
    Params P{};
    const float** pp = (const float**)&P;
    for (int i = 0; i < 21; ++i) pp[i] = (const float*)d_in[i];
    P.out = (float*)d_out; P.ws = (unsigned char*)d_ws;
    void* args[] = {&P};
    hipError_t e = hipLaunchCooperativeKernel((const void*)fwd_kernel, dim3(grid_blocks), dim3(512), args, LDS_BYTES, stream);
    if (e != hipSuccess) fprintf(stderr, "cooperative launch failed: %s (grid %d)\n", hipGetErrorString(e), grid_blocks);
}
```

```cpp
#include <hip/hip_runtime.h>
#include <hip/hip_cooperative_groups.h>
#include <cstdio>
#include <cstdint>
namespace cg = cooperative_groups;
namespace pg8 {
#define PG8_LAS __attribute__((address_space(3)))
typedef unsigned short bf16_t;
typedef short bf16x8 __attribute__((ext_vector_type(8)));
typedef float f32x4 __attribute__((ext_vector_type(4)));
typedef unsigned u32x4 __attribute__((ext_vector_type(4)));
constexpr int BM = 256, BK = 64, HALF = 128, HTB = HALF * BK * 2  , STAGE_BYTES = 8 * HTB, NXCD = 8, WGM = 8;

__host__ __device__ __forceinline__ int lds_byte(int r, int c) { const int st = (r >> 4) * 2 + (c >> 5), rr = r & 15, cc = c & 31, ob = rr * 64 + cc * 2; return st * 1024 + (ob ^ (((ob >> 9) & 1) << 5)); }
__host__ __device__ __forceinline__ void stage_rc(int b, int& R, int& C) { const int st = b / 1024, sb = b % 1024, swz = sb ^ (((sb >> 9) & 1) << 5); R = (st >> 1) * 16 + swz / 64; C = (st & 1) * 32 + (swz % 64) / 2; }
__host__ __device__ __forceinline__ int perm32(int rho) { const int n = rho >> 4, i = rho & 15; return 8 * (i >> 2) + 4 * n + (i & 3); }

struct Unit { int pm, pn; int sel; };
struct Gemm { const bf16_t* A; const bf16_t* Bt; int M, N, K; int lda = 0, ldb = 0; const bf16_t* A2 = nullptr; const bf16_t* Bt2 = nullptr; };

struct StaticOrder {
    int nM, nN, nwg, G, c;
    __host__ __device__ void init(int M, int N, int G_, int c_) { nM = M / BM; nN = N / BM; nwg = nM * nN; G = G_; c = c_; }
    __host__ __device__ bool next(int i, Unit& u) const {
        const long L = (long)i * G + c; if (L >= nwg) return false;
        int wgid = (int)L; { const int q = nwg / NXCD, r = nwg % NXCD, xcd = wgid % NXCD, off = wgid / NXCD; wgid = (xcd < r ? xcd * (q + 1) : r * (q + 1) + (xcd - r) * q) + off; }
        const int nig = WGM * nN, gid = wgid / nig, fm = gid * WGM, gsz = (nM - fm) < WGM ? (nM - fm) : WGM;
        u.pm = fm + ((wgid % nig) % gsz); u.pn = (wgid % nig) / gsz; u.sel = 0; return true;
    }
    __device__ __forceinline__ void a_ready(const Unit&) const {}
    __device__ __forceinline__ void done(const Unit&) const {}
};

struct DualOrder {
    StaticOrder b;
    __host__ __device__ bool next(int i, Unit& u) const { const bool ok = b.next(i >> 1, u); u.sel = i & 1; return ok; }
    __device__ __forceinline__ void a_ready(const Unit&) const {}
    __device__ __forceinline__ void done(const Unit&) const {}
};
__device__ __forceinline__ unsigned cvt_pk_bf16(float lo, float hi) { unsigned r; asm volatile("v_cvt_pk_bf16_f32 %0, %1, %2" : "=v"(r) : "v"(lo), "v"(hi)); return r; }
typedef float f32x2 __attribute__((ext_vector_type(2)));
template <class Epi, class Sched, bool ALIGN_EPI = false, bool SP2 = false>
__device__ __forceinline__ void gemm_phase(PG8_LAS unsigned char* lds, const Gemm g, const Sched& S, const Epi& E, int tid_in) {
    int tid_ = tid_in; asm volatile("" : "+v"(tid_));
    const int tid = tid_, wid = __builtin_amdgcn_readfirstlane(tid >> 6), lane = tid & 63, wr = wid >> 2, wc = wid & 3, fr = lane & 15, fq = lane >> 4;
    const int K = g.K, nt = K / BK, lda = g.lda ? g.lda : K, ldb = g.ldb ? g.ldb : K;
    unsigned voffA[2], voffB[2];
#pragma unroll
    for (int i = 0; i < 2; ++i) { int R, C; stage_rc(tid * 16 + i * 8192, R, C); const int Rb = Epi::PERM ? ((R & ~31) + perm32(R & 31)) : R;
        voffA[i] = (unsigned)(R * lda + C) * 2u; voffB[i] = (unsigned)(Rb * ldb + C) * 2u; }
    const size_t kstep = (size_t)(BK * 2);
    const size_t hstepA = (size_t)HALF * lda * 2, hstepB = (size_t)HALF * ldb * 2;
    const size_t tstepA = 2 * hstepA, tstepB = 2 * hstepB;
    const unsigned ldsw = (unsigned)wid * 1024u;
    const int aoff = lds_byte(wr * 64 + fr, fq * 8), boff = lds_byte(wc * 32 + fr, fq * 8);
#define PG8_SA(b, h) (((b) * 2 + (h)) * HTB)
#define PG8_SB(b, h) ((4 + (b) * 2 + (h)) * HTB)
#define PG8_STAGE(bufoff, gbase, voff) do { _Pragma("unroll") for (int _i = 0; _i < 2; ++_i) \
        __builtin_amdgcn_global_load_lds((const unsigned*)((const char*)(gbase) + (voff)[_i]), (PG8_LAS unsigned*)(lds + (bufoff) + ldsw + _i * 8192), 16, 0, 0); } while (0)
#define PG8_LDA(dst, b, h) do { _Pragma("unroll") for (int m = 0; m < 4; ++m) _Pragma("unroll") for (int k = 0; k < 2; ++k) dst[m][k] = *(const PG8_LAS bf16x8*)(lds + PG8_SA(b, h) + aoff + m * 2048 + k * 1024); } while (0)
#define PG8_LDB(dst, b, h) do { _Pragma("unroll") for (int n = 0; n < 2; ++n) _Pragma("unroll") for (int k = 0; k < 2; ++k) dst[n][k] = *(const PG8_LAS bf16x8*)(lds + PG8_SB(b, h) + boff + n * 2048 + k * 1024); } while (0)
#define PG8_MMA(ai, bj, At, Bt) do { __builtin_amdgcn_s_setprio(1); _Pragma("unroll") for (int m = 0; m < 4; ++m) _Pragma("unroll") for (int n = 0; n < 2; ++n) _Pragma("unroll") for (int k = 0; k < 2; ++k) \
        acc[ai][bj][m][n] = __builtin_amdgcn_mfma_f32_16x16x32_bf16(Bt[n][k], At[m][k], acc[ai][bj][m][n], 0, 0, 0); __builtin_amdgcn_s_setprio(0); } while (0)
#define PG8_WAIT_V(n) asm volatile("s_waitcnt vmcnt(" #n ")" ::: "memory")
#define PG8_WAIT_L(n) asm volatile("s_waitcnt lgkmcnt(" #n ")" ::: "memory")
#define PG8_BAR __builtin_amdgcn_s_barrier()
#define PG8_SCHED __builtin_amdgcn_sched_barrier(0)
    Unit cur, nxt; int ui = 0;
    if (!S.next(0, cur)) return;
    f32x4 acc[2][2][4][2];
#pragma unroll
    for (int a = 0; a < 2; ++a)
#pragma unroll
        for (int b = 0; b < 2; ++b)
#pragma unroll
            for (int m = 0; m < 4; ++m)
#pragma unroll
                for (int n = 0; n < 2; ++n) acc[a][b][m][n] = (f32x4){0.f, 0.f, 0.f, 0.f};
    bf16x8 At[4][2], B0[2][2], B1[2][2];
    const char* cA = (const char*)(cur.sel ? g.A2 : g.A) + (size_t)cur.pm * tstepA; const char* cB = (const char*)(cur.sel ? g.Bt2 : g.Bt) + (size_t)cur.pn * tstepB;
    S.a_ready(cur);
    if constexpr (SP2) {
        PG8_STAGE(PG8_SB(0, 0), cB, voffB); PG8_STAGE(PG8_SB(0, 1), cB + hstepB, voffB); PG8_STAGE(PG8_SA(0, 0), cA, voffA); PG8_STAGE(PG8_SA(0, 1), cA + hstepA, voffA);
        if (wr == 1) PG8_BAR;
        PG8_WAIT_V(2); PG8_BAR;
        PG8_STAGE(PG8_SB(1, 0), cB + kstep, voffB); PG8_STAGE(PG8_SA(1, 0), cA + kstep, voffA); PG8_STAGE(PG8_SB(1, 1), cB + hstepB + kstep, voffB);
        PG8_WAIT_V(6); PG8_BAR;
    } else {
        PG8_STAGE(PG8_SB(0, 0), cB, voffB); PG8_STAGE(PG8_SA(0, 0), cA, voffA); PG8_STAGE(PG8_SB(0, 1), cB + hstepB, voffB); PG8_STAGE(PG8_SA(0, 1), cA + hstepA, voffA);
        if (wr == 1) PG8_BAR;
        PG8_WAIT_V(4); PG8_BAR;
        PG8_STAGE(PG8_SB(1, 0), cB + kstep, voffB); PG8_STAGE(PG8_SA(1, 0), cA + kstep, voffA); PG8_STAGE(PG8_SB(1, 1), cB + hstepB + kstep, voffB);
        PG8_WAIT_V(6); PG8_BAR;
    }
    for (;;) {
        const bool has_next = S.next(ui + 1, nxt);
        const char* nA = has_next ? (const char*)(nxt.sel ? g.A2 : g.A) + (size_t)nxt.pm * tstepA : cA; const char* nB = has_next ? (const char*)(nxt.sel ? g.Bt2 : g.Bt) + (size_t)nxt.pn * tstepB : cB;
        for (int t = 0; t < nt; t += 2) {
            const bool last = (t == nt - 2);
            const char* a1 = cA + (size_t)(t + 1) * kstep;
            const char* a2 = last ? nA : cA + (size_t)(t + 2) * kstep; const char* b2 = last ? nB : cB + (size_t)(t + 2) * kstep;
            const char* a3 = a2 + kstep; const char* b3 = b2 + kstep;
            if (last && has_next) S.a_ready(nxt);
            if constexpr (SP2) {
            PG8_LDB(B0, 0, 0); PG8_LDB(B1, 0, 1); PG8_SCHED; PG8_LDA(At, 0, 0); PG8_STAGE(PG8_SA(1, 1), a1 + hstepA, voffA);
            PG8_WAIT_V(8); PG8_WAIT_L(0); PG8_BAR; PG8_MMA(0, 0, At, B0); PG8_MMA(0, 1, At, B1); PG8_BAR; PG8_SCHED;
            PG8_LDA(At, 0, 1); PG8_STAGE(PG8_SB(0, 0), b2, voffB); PG8_STAGE(PG8_SB(0, 1), b2 + hstepB, voffB); PG8_STAGE(PG8_SA(0, 0), a2, voffA);
            PG8_WAIT_V(8); PG8_WAIT_L(0); PG8_BAR; PG8_MMA(1, 0, At, B0); PG8_MMA(1, 1, At, B1); PG8_BAR; PG8_SCHED;
            PG8_LDB(B0, 1, 0); PG8_LDB(B1, 1, 1); PG8_SCHED; PG8_LDA(At, 1, 0); PG8_STAGE(PG8_SA(0, 1), a2 + hstepA, voffA);
            PG8_WAIT_V(8); PG8_WAIT_L(0); PG8_BAR; PG8_MMA(0, 0, At, B0); PG8_MMA(0, 1, At, B1); PG8_BAR; PG8_SCHED;
            PG8_LDA(At, 1, 1); PG8_STAGE(PG8_SB(1, 0), b3, voffB); PG8_STAGE(PG8_SB(1, 1), b3 + hstepB, voffB); PG8_STAGE(PG8_SA(1, 0), a3, voffA);
            PG8_WAIT_V(8); PG8_WAIT_L(0); PG8_BAR; PG8_MMA(1, 0, At, B0); PG8_MMA(1, 1, At, B1); PG8_BAR; PG8_SCHED;
            } else {
            PG8_LDB(B0, 0, 0); PG8_SCHED; PG8_LDA(At, 0, 0); PG8_STAGE(PG8_SA(1, 1), a1 + hstepA, voffA);
            PG8_WAIT_L(8); PG8_BAR; PG8_WAIT_L(0); PG8_MMA(0, 0, At, B0); PG8_BAR; PG8_SCHED;
            PG8_LDB(B1, 0, 1); PG8_STAGE(PG8_SB(0, 0), b2, voffB);
            PG8_BAR; PG8_WAIT_L(0); PG8_MMA(0, 1, At, B1); PG8_BAR;
            PG8_LDA(At, 0, 1); PG8_STAGE(PG8_SA(0, 0), a2, voffA);
            PG8_BAR; PG8_WAIT_L(0); PG8_MMA(1, 0, At, B0); PG8_BAR; PG8_SCHED;
            PG8_STAGE(PG8_SB(0, 1), b2 + hstepB, voffB);
            PG8_WAIT_V(6); PG8_BAR; PG8_MMA(1, 1, At, B1); PG8_BAR;
            PG8_LDB(B0, 1, 0); PG8_SCHED; PG8_LDA(At, 1, 0); PG8_STAGE(PG8_SA(0, 1), a2 + hstepA, voffA);
            PG8_WAIT_L(8); PG8_BAR; PG8_WAIT_L(0); PG8_MMA(0, 0, At, B0); PG8_BAR; PG8_SCHED;
            PG8_LDB(B1, 1, 1); PG8_STAGE(PG8_SB(1, 0), b3, voffB);
            PG8_BAR; PG8_WAIT_L(0); PG8_MMA(0, 1, At, B1); PG8_BAR;
            PG8_LDA(At, 1, 1); PG8_STAGE(PG8_SA(1, 0), a3, voffA);
            PG8_BAR; PG8_WAIT_L(0); PG8_MMA(1, 0, At, B0); PG8_BAR; PG8_SCHED;
            PG8_STAGE(PG8_SB(1, 1), b3 + hstepB, voffB);
            PG8_WAIT_V(6); PG8_BAR; PG8_MMA(1, 1, At, B1); PG8_BAR;
            }
        }
        if constexpr (ALIGN_EPI) { if (wr == 0) PG8_BAR; }
        if constexpr (!Epi::AFTER_DRAIN) { E(acc, cur, wr, wc, fr, fq); S.done(cur); }
        if (!has_next) break;
        if (!Epi::DUAL || cur.sel == 1) {
#pragma unroll
        for (int a = 0; a < 2; ++a)
#pragma unroll
            for (int b = 0; b < 2; ++b)
#pragma unroll
                for (int m = 0; m < 4; ++m)
#pragma unroll
                    for (int n = 0; n < 2; ++n) acc[a][b][m][n] = (f32x4){0.f, 0.f, 0.f, 0.f};
        }
        cur = nxt; cA = nA; cB = nB; ++ui;
        if constexpr (ALIGN_EPI) { if (wr == 1) PG8_BAR; }
    }
    PG8_WAIT_V(0);
    if constexpr (!ALIGN_EPI) { if (wr == 0) PG8_BAR; }
    PG8_BAR;
    if constexpr (Epi::AFTER_DRAIN) { E.fused(acc, cur, wr, wc, fr, fq, lds, wid, lane); S.done(cur); }
#undef PG8_SA
#undef PG8_SB
#undef PG8_STAGE
#undef PG8_LDA
#undef PG8_LDB
#undef PG8_MMA
#undef PG8_WAIT_V
#undef PG8_WAIT_L
#undef PG8_BAR
#undef PG8_SCHED
}
}

#define LAS __attribute__((address_space(3)))
typedef unsigned short bf16_t;
typedef short bf16x8 __attribute__((ext_vector_type(8)));
typedef short s16x4 __attribute__((ext_vector_type(4)));
typedef float f32x4 __attribute__((ext_vector_type(4)));
typedef float f32x16 __attribute__((ext_vector_type(16)));
typedef unsigned u32x4 __attribute__((ext_vector_type(4)));
typedef unsigned u32x2 __attribute__((ext_vector_type(2)));

constexpr int DM = 1024, MP = 65536, MS_ = 32768, MT = 98304, SP = 8192, SS = 16384, DFF = 2816;
constexpr int NIN = 3840;
constexpr float EPSN = 1e-6f;
constexpr float LOG2E = 1.4426950408889634f;
constexpr float QS_NA = 0.125f * LOG2E;
constexpr float QS_M = 0.10206207261596575f * LOG2E;

constexpr size_t MiB = 1u << 20;
constexpr size_t W_IN = 0, W_VNA = W_IN + (size_t)NIN * 1024 * 2, W_UQ = W_VNA + 512 * 1024 * 2, W_UK = W_UQ + 768 * 384 * 2, W_UV = W_UK + 512 * 256 * 2,
                 W_NAO = W_UV + 512 * 256 * 2, W_MLAO = W_NAO + 1024 * 512 * 2, W_OUT = W_MLAO + 1024 * 512 * 2, W_GU = W_OUT + 1024 * 1024 * 2,
                 W_DN = W_GU + (size_t)5632 * 1024 * 2, W_PG = W_DN + (size_t)1024 * 2816 * 2, W_PL = W_PG + 1024 * 1024 * 2, W_END = W_PL + 1024 * 256 * 2;
static_assert(W_END <= 34 * MiB, "weights region");
constexpr size_t WS_CTL = 33 * MiB, CTL_BYTES = 16384;
static_assert(W_END <= WS_CTL, "ctl after weights");
constexpr size_t WS_ROPE = 34 * MiB;
constexpr size_t WS_RSQ = 36 * MiB;
constexpr size_t WS_KROPE = 38 * MiB;
constexpr size_t WS_PB = 44 * MiB;
constexpr size_t WS_XN = 92 * MiB;
constexpr size_t WS_QNA = 284 * MiB, WS_KNA = 380 * MiB, WS_VTNA = 476 * MiB;
constexpr size_t WS_ZLAT = 572 * MiB;
constexpr size_t WS_ZQN = 716 * MiB, WS_ZKVN = 788 * MiB;
constexpr size_t WS_QM = 92 * MiB;
constexpr size_t WS_KN = 716 * MiB;
constexpr size_t WS_VTM = 836 * MiB;
constexpr size_t WS_MLAO = 572 * MiB;
constexpr size_t WS_T1 = 92 * MiB;
constexpr size_t WS_U = 380 * MiB;
constexpr size_t WS_XB1 = 92 * MiB;
constexpr size_t WS_H = 284 * MiB;
constexpr size_t WS_XB2 = 92 * MiB;
constexpr size_t WS_PW = 284 * MiB;
constexpr size_t WS_NEED = 932 * MiB;

#ifndef PHASES
#define PHASES 0x7ff
#endif
constexpr int LDS_BYTES = 147456;

struct Params {
    const float *x_p, *x_s, *p_p, *p_s, *g_mix, *w_in, *rpb, *g_q, *w_uq, *g_kv, *w_ukv, *w_nao, *w_mlao, *w_out, *g_ffn, *w_gu, *w_dn, *g_ple, *w_pg, *w_pl, *g_fin;
    float* out; unsigned char* ws;
};

__device__ __forceinline__ unsigned pk2(float lo, float hi) { return pg8::cvt_pk_bf16(lo, hi); }
__device__ __forceinline__ float bf2f(unsigned short b) { return __uint_as_float((unsigned)b << 16); }
__device__ __forceinline__ float bflo(unsigned w) { return __uint_as_float(w << 16); }
__device__ __forceinline__ float bfhi(unsigned w) { return __uint_as_float(w & 0xffff0000u); }
__device__ __forceinline__ float sigmoidf_(float x) { return __builtin_amdgcn_rcpf(1.0f + __builtin_amdgcn_exp2f(-x * LOG2E)); }
__device__ __forceinline__ void store8(bf16_t* p, f32x4 a, f32x4 b) { u32x4 w; w.x = pk2(a[0], a[1]); w.y = pk2(a[2], a[3]); w.z = pk2(b[0], b[1]); w.w = pk2(b[2], b[3]); *(u32x4*)p = w; }
__device__ __forceinline__ float wave_sum(float v) {
#pragma unroll
    for (int o = 1; o < 64; o <<= 1) v += __shfl_xor(v, o);
    return v;
}
__device__ __forceinline__ int opq(int v) { asm volatile("" : "+s"(v)); return v; }
__device__ __forceinline__ int my_lane() { int l; asm volatile("v_mbcnt_lo_u32_b32 %0, -1, 0\n\tv_mbcnt_hi_u32_b32 %0, -1, %0" : "=v"(l)); return l; }
__device__ __forceinline__ int row_pos(int row) { return row < MP ? (row & (SP - 1)) : (row & (SS - 1)); }

typedef f32x4 Acc[2][2][4][2];
#define EPI_ROWS(ai, m) (u.pm * 256 + (ai) * 128 + wr * 64 + (m) * 16 + fr)
#define EPI_COL(bj) (u.pn * 256 + (bj) * 128 + wc * 32 + 8 * fq)

__device__ __forceinline__ void rowsum_atomic4(float* dst, const float (&ss)[4], int row0  , int fq) {
    const float v = fq == 0 ? ss[0] : fq == 1 ? ss[1] : fq == 2 ? ss[2] : ss[3];
    unsafeAtomicAdd(dst + row0 + 16 * fq, v);
}
struct EpiIn {
    static constexpr bool PERM = true, AFTER_DRAIN = false, DUAL = false;
    bf16_t *qna, *kna, *gates, *zlat; float *rsq_q, *rsq_kv;
    __device__ __forceinline__ void operator()(const Acc& acc, const pg8::Unit& u, int wr, int wc, int fr, int fq) const {
        const int pn = u.pn; bf16_t* base; int ldc, cb, mode;
        if (pn < 2) { base = qna; ldc = 512; cb = pn * 256; mode = 1; }
        else if (pn < 4) { base = kna; ldc = 512; cb = (pn - 2) * 256; mode = 0; }
        else if (pn < 12) { base = gates; ldc = 2048; cb = (pn - 4) * 256; mode = 2; }
        else { base = zlat; ldc = 768; cb = (pn - 12) * 256; mode = 0; }
        const float sc = mode == 1 ? QS_NA : 1.0f;
#pragma unroll
        for (int ai = 0; ai < 2; ++ai) { float sq[4] = {0.f, 0.f, 0.f, 0.f}, sk[4] = {0.f, 0.f, 0.f, 0.f};
#pragma unroll
            for (int m = 0; m < 4; ++m) {
                bf16_t* rowp = base + (size_t)EPI_ROWS(ai, m) * ldc + cb + wc * 32 + 8 * fq;
#pragma unroll
                for (int bj = 0; bj < 2; ++bj) {
                    f32x4 v0 = acc[ai][bj][m][0], v1 = acc[ai][bj][m][1];
                    if (mode == 2) {
#pragma unroll
                        for (int e = 0; e < 4; ++e) { v0[e] = sigmoidf_(v0[e]); v1[e] = sigmoidf_(v1[e]); }
                    } else { v0 = v0 * sc; v1 = v1 * sc; }
                    store8(rowp + bj * 128, v0, v1);
                    if (pn >= 12) {
                        const bool isq = (pn == 12 || (pn == 13 && bj == 0)), iskv = !isq && (pn == 13 || bj == 0);
                        if (isq || iskv) { float ss = (v0[0] * v0[0] + v0[1] * v0[1]) + (v0[2] * v0[2] + v0[3] * v0[3]) + (v1[0] * v1[0] + v1[1] * v1[1]) + (v1[2] * v1[2] + v1[3] * v1[3]);
                            ss += __shfl_xor(ss, 16); ss += __shfl_xor(ss, 32);
                            if (isq) sq[m] += ss; else sk[m] += ss; }
                    }
                }
            }
            if (pn >= 12) { if (pn <= 13) rowsum_atomic4(rsq_q, sq, EPI_ROWS(ai, 0), fq); if (pn >= 13) rowsum_atomic4(rsq_kv, sk, EPI_ROWS(ai, 0), fq); }
        }
    }
};
struct EpiPlain {
    static constexpr bool PERM = true, AFTER_DRAIN = false, DUAL = false;
    bf16_t* O; int ldc;
    __device__ __forceinline__ void operator()(const Acc& acc, const pg8::Unit& u, int wr, int wc, int fr, int fq) const {
#pragma unroll
        for (int ai = 0; ai < 2; ++ai)
#pragma unroll
            for (int m = 0; m < 4; ++m) {
                bf16_t* rowp = O + (size_t)EPI_ROWS(ai, m) * ldc + EPI_COL(0);
#pragma unroll
                for (int bj = 0; bj < 2; ++bj) store8(rowp + bj * 128, acc[ai][bj][m][0], acc[ai][bj][m][1]);
            }
    }
};
struct EpiPlainPermT {
    static constexpr bool PERM = true, AFTER_DRAIN = false, DUAL = false;
    bf16_t* O; int ldc;
    __device__ __forceinline__ void operator()(const Acc& acc, const pg8::Unit& u, int wr, int wc, int fr, int fq) const {
#pragma unroll
        for (int bj = 0; bj < 2; ++bj) { const int col = EPI_COL(bj);
#pragma unroll
            for (int ai = 0; ai < 2; ++ai)
#pragma unroll
                for (int m = 0; m < 4; ++m) { const f32x4 v0 = acc[ai][bj][m][0], v1 = acc[ai][bj][m][1];
                    bf16_t* p = O + (size_t)EPI_ROWS(ai, m) * ldc + (col & ~15) + ((col & 8) ? 4 : 0);
                    u32x2 w0, w1; w0.x = pk2(v0[0], v0[1]); w0.y = pk2(v0[2], v0[3]); w1.x = pk2(v1[0], v1[1]); w1.y = pk2(v1[2], v1[3]);
                    *(u32x2*)p = w0; *(u32x2*)(p + 8) = w1; } }
    }
};
struct EpiRowScale {
    static constexpr bool PERM = true, AFTER_DRAIN = false, DUAL = false;
    bf16_t* O; int ldc; const float* rsq; float invn;
    __device__ __forceinline__ void operator()(const Acc& acc, const pg8::Unit& u, int wr, int wc, int fr, int fq) const {
        float rq[2][4];
#pragma unroll
        for (int ai = 0; ai < 2; ++ai)
#pragma unroll
            for (int m = 0; m < 4; ++m) rq[ai][m] = rsq[EPI_ROWS(ai, m)];
#pragma unroll
        for (int ai = 0; ai < 2; ++ai)
#pragma unroll
            for (int m = 0; m < 4; ++m) {
                const float rstd = __builtin_amdgcn_rsqf(rq[ai][m] * invn + EPSN);
                bf16_t* rowp = O + (size_t)EPI_ROWS(ai, m) * ldc + EPI_COL(0);
#pragma unroll
                for (int bj = 0; bj < 2; ++bj) store8(rowp + bj * 128, acc[ai][bj][m][0] * rstd, acc[ai][bj][m][1] * rstd);
            }
    }
};
struct EpiColScale {
    static constexpr bool PERM = true, AFTER_DRAIN = false, DUAL = false;
    bf16_t* O; int ldc; const float* rsq; float invn;
    __device__ __forceinline__ void operator()(const Acc& acc, const pg8::Unit& u, int wr, int wc, int fr, int fq) const {
#pragma unroll
        for (int bj = 0; bj < 2; ++bj) {
            const int col = EPI_COL(bj);
            f32x4 r0 = *(const f32x4*)(rsq + col), r1 = *(const f32x4*)(rsq + col + 4);
#pragma unroll
            for (int e = 0; e < 4; ++e) { r0[e] = __builtin_amdgcn_rsqf(r0[e] * invn + EPSN); r1[e] = __builtin_amdgcn_rsqf(r1[e] * invn + EPSN); }
#pragma unroll
            for (int ai = 0; ai < 2; ++ai)
#pragma unroll
                for (int m = 0; m < 4; ++m) {
                    const f32x4 v0 = acc[ai][bj][m][0] * r0, v1 = acc[ai][bj][m][1] * r1;
                    bf16_t* p = O + (size_t)EPI_ROWS(ai, m) * ldc + (col & ~15) + ((col & 8) ? 4 : 0);
                    u32x2 w0, w1; w0.x = pk2(v0[0], v0[1]); w0.y = pk2(v0[2], v0[3]); w1.x = pk2(v1[0], v1[1]); w1.y = pk2(v1[2], v1[3]);
                    *(u32x2*)p = w0; *(u32x2*)(p + 8) = w1; }
        }
    }
};
struct EpiQRope {
    static constexpr bool PERM = true, AFTER_DRAIN = false, DUAL = false;
    bf16_t* Qm; const float2* tab; const float* rsq;
    __device__ __forceinline__ void operator()(const Acc& acc, const pg8::Unit& u, int wr, int wc, int fr, int fq) const {
        const bool rope0 = ((u.pn * 8 + wc) % 3) == 2, rope1 = ((u.pn * 8 + 4 + wc) % 3) == 2, anyrope = rope0 || rope1;
#pragma unroll
        for (int ai = 0; ai < 2; ++ai) {
            f32x4 cs[4][2]; float rq[4];
#pragma unroll
            for (int m = 0; m < 4; ++m) rq[m] = rsq[EPI_ROWS(ai, m)];
            if (anyrope) {
#pragma unroll
                for (int m = 0; m < 4; ++m) { const f32x4* t = (const f32x4*)(tab + (size_t)row_pos(EPI_ROWS(ai, m)) * 16 + 4 * fq); cs[m][0] = t[0]; cs[m][1] = t[1]; }
            }
#pragma unroll
            for (int m = 0; m < 4; ++m) {
                const int row = EPI_ROWS(ai, m);
#pragma unroll
                for (int bj = 0; bj < 2; ++bj) {
                    const float sc = QS_M * __builtin_amdgcn_rsqf(rq[m] * (1.0f / 384.0f) + EPSN);
                    f32x4 v0 = acc[ai][bj][m][0] * sc, v1 = acc[ai][bj][m][1] * sc;
                    if (bj == 0 ? rope0 : rope1) {
#pragma unroll
                        for (int e = 0; e < 4; ++e) { const float cc = cs[m][e >> 1][2 * (e & 1)], sn = cs[m][e >> 1][2 * (e & 1) + 1]; const float a = v0[e], b = v1[e]; v0[e] = a * cc - b * sn; v1[e] = b * cc + a * sn; }
                    }
                    store8(Qm + (size_t)row * 768 + EPI_COL(bj), v0, v1);
                }
            }
            asm volatile("" ::: "memory");
        }
    }
};
struct EpiGateDual {
    static constexpr bool PERM = true, AFTER_DRAIN = false, DUAL = true;
    bf16_t* U; const bf16_t* gates;
    __device__ __forceinline__ void operator()(Acc& acc, const pg8::Unit& u, int wr, int wc, int fr, int fq) const {
        if (u.sel == 0) {
#pragma unroll
            for (int ai = 0; ai < 2; ++ai)
#pragma unroll
                for (int mp = 0; mp < 2; ++mp) {
                    u32x4 ga[2][2], gb[2][2];
#pragma unroll
                    for (int mm = 0; mm < 2; ++mm)
#pragma unroll
                        for (int bj = 0; bj < 2; ++bj) { const bf16_t* gp = gates + (size_t)EPI_ROWS(ai, 2 * mp + mm) * 2048 + EPI_COL(bj); ga[mm][bj] = *(const u32x4*)gp; gb[mm][bj] = *(const u32x4*)(gp + 1024); }
#pragma unroll
                    for (int mm = 0; mm < 2; ++mm)
#pragma unroll
                        for (int bj = 0; bj < 2; ++bj) { const int m = 2 * mp + mm; const u32x4 a = ga[mm][bj], b = gb[mm][bj];
#define RATIO_(x, y) ((x) * __builtin_amdgcn_rcpf(fmaxf((y), 1e-30f)))
                            acc[ai][bj][m][0][0] *= RATIO_(bflo(a.x), bflo(b.x)); acc[ai][bj][m][0][1] *= RATIO_(bfhi(a.x), bfhi(b.x)); acc[ai][bj][m][0][2] *= RATIO_(bflo(a.y), bflo(b.y)); acc[ai][bj][m][0][3] *= RATIO_(bfhi(a.y), bfhi(b.y));
                            acc[ai][bj][m][1][0] *= RATIO_(bflo(a.z), bflo(b.z)); acc[ai][bj][m][1][1] *= RATIO_(bfhi(a.z), bfhi(b.z)); acc[ai][bj][m][1][2] *= RATIO_(bflo(a.w), bflo(b.w)); acc[ai][bj][m][1][3] *= RATIO_(bfhi(a.w), bfhi(b.w));
#undef RATIO_
                        }
                    asm volatile("" ::: "memory");
                }
        } else {
#pragma unroll
            for (int ai = 0; ai < 2; ++ai) {
                u32x4 g[4][2];
#pragma unroll
                for (int m = 0; m < 4; ++m)
#pragma unroll
                    for (int bj = 0; bj < 2; ++bj) g[m][bj] = *(const u32x4*)(gates + (size_t)EPI_ROWS(ai, m) * 2048 + 1024 + EPI_COL(bj));
#pragma unroll
                for (int m = 0; m < 4; ++m)
#pragma unroll
                    for (int bj = 0; bj < 2; ++bj) { const u32x4 gg = g[m][bj];
                        f32x4 v0 = acc[ai][bj][m][0], v1 = acc[ai][bj][m][1];
                        v0[0] *= bflo(gg.x); v0[1] *= bfhi(gg.x); v0[2] *= bflo(gg.y); v0[3] *= bfhi(gg.y);
                        v1[0] *= bflo(gg.z); v1[1] *= bfhi(gg.z); v1[2] *= bflo(gg.w); v1[3] *= bfhi(gg.w);
                        store8(U + (size_t)EPI_ROWS(ai, m) * 1024 + EPI_COL(bj), v0, v1); }
                asm volatile("" ::: "memory");
            }
        }
    }
};
template <bool BASE_BF16> struct EpiResid {
    static constexpr bool PERM = true, AFTER_DRAIN = false, DUAL = false;
    const float* base_p; const float* base_s;
    const bf16_t* base_b; bf16_t* XB; float* rowsq;
    __device__ __forceinline__ void operator()(const Acc& acc, const pg8::Unit& u, int wr, int wc, int fr, int fq) const {
#pragma unroll
        for (int ai = 0; ai < 2; ++ai) { float ssv[4];
#pragma unroll
            for (int mp = 0; mp < 2; ++mp) {
                f32x4 b[2][2][2];
#pragma unroll
                for (int mm = 0; mm < 2; ++mm) { const int row = EPI_ROWS(ai, 2 * mp + mm);
                    if (BASE_BF16) {
#pragma unroll
                        for (int bj = 0; bj < 2; ++bj) { const u32x4 t = *(const u32x4*)(base_b + (size_t)row * 1024 + EPI_COL(bj));
                            b[mm][bj][0] = (f32x4){bflo(t.x), bfhi(t.x), bflo(t.y), bfhi(t.y)}; b[mm][bj][1] = (f32x4){bflo(t.z), bfhi(t.z), bflo(t.w), bfhi(t.w)}; }
                    } else {
                        const float* brow = row < MP ? base_p + (size_t)row * 1024 : base_s + (size_t)(row - MP) * 1024;
#pragma unroll
                        for (int bj = 0; bj < 2; ++bj) { b[mm][bj][0] = *(const f32x4*)(brow + EPI_COL(bj)); b[mm][bj][1] = *(const f32x4*)(brow + EPI_COL(bj) + 4); }
                    } }
#pragma unroll
                for (int mm = 0; mm < 2; ++mm) { const int m = 2 * mp + mm, row = EPI_ROWS(ai, m); float ss = 0.f;
#pragma unroll
                    for (int bj = 0; bj < 2; ++bj) { const int col = EPI_COL(bj);
                        const f32x4 v0 = acc[ai][bj][m][0] + b[mm][bj][0], v1 = acc[ai][bj][m][1] + b[mm][bj][1];
                        store8(XB + (size_t)row * 1024 + col, v0, v1);
                        ss += (v0[0] * v0[0] + v0[1] * v0[1]) + (v0[2] * v0[2] + v0[3] * v0[3]) + (v1[0] * v1[0] + v1[1] * v1[1]) + (v1[2] * v1[2] + v1[3] * v1[3]); }
                    ss += __shfl_xor(ss, 16); ss += __shfl_xor(ss, 32);
                    ssv[m] = ss; }
                asm volatile("" ::: "memory");
            }
            rowsum_atomic4(rowsq, ssv, EPI_ROWS(ai, 0), fq); }
    }
};
struct EpiGLU {
    static constexpr bool PERM = true, AFTER_DRAIN = false, DUAL = false;
    bf16_t* H; const float* rowsq;
    __device__ __forceinline__ void operator()(const Acc& acc, const pg8::Unit& u, int wr, int wc, int fr, int fq) const {
        float rq[2][4];
#pragma unroll
        for (int ai = 0; ai < 2; ++ai)
#pragma unroll
            for (int m = 0; m < 4; ++m) rq[ai][m] = rowsq[EPI_ROWS(ai, m)];
#pragma unroll
        for (int ai = 0; ai < 2; ++ai)
#pragma unroll
            for (int m = 0; m < 4; ++m) {
                const int row = EPI_ROWS(ai, m);
                const float rstd = __builtin_amdgcn_rsqf(rq[ai][m] * (1.0f / 1024.0f) + EPSN);
#pragma unroll
                for (int bj = 0; bj < 2; ++bj) {
                    const int hc = u.pn * 128 + bj * 64 + wc * 16 + 4 * fq;
                    const f32x4 g = acc[ai][bj][m][0] * rstd, up = acc[ai][bj][m][1] * rstd;
                    float h[4];
#pragma unroll
                    for (int e = 0; e < 4; ++e) h[e] = g[e] * sigmoidf_(g[e]) * up[e];
                    u32x2 w; w.x = pk2(h[0], h[1]); w.y = pk2(h[2], h[3]);
                    *(u32x2*)(H + (size_t)row * DFF + hc) = w;
                }
            }
    }
};
struct EpiPle {
    static constexpr bool PERM = true, AFTER_DRAIN = false, DUAL = false;
    const bf16_t* X2B; bf16_t* X3B; const bf16_t* PW; const float* rowsq2; float* rowsq3;
    __device__ __forceinline__ void operator()(const Acc& acc, const pg8::Unit& u, int wr, int wc, int fr, int fq) const {
        float rq[2][4];
#pragma unroll
        for (int ai = 0; ai < 2; ++ai)
#pragma unroll
            for (int m = 0; m < 4; ++m) rq[ai][m] = rowsq2[EPI_ROWS(ai, m)];
#pragma unroll
        for (int ai = 0; ai < 2; ++ai) { float ssv[4];
#pragma unroll
            for (int mp = 0; mp < 2; ++mp) {
                u32x4 xb[2][2], t[2][2];
#pragma unroll
                for (int mm = 0; mm < 2; ++mm)
#pragma unroll
                    for (int bj = 0; bj < 2; ++bj) { const size_t off = (size_t)EPI_ROWS(ai, 2 * mp + mm) * 1024 + EPI_COL(bj);
                        xb[mm][bj] = *(const u32x4*)(X2B + off); t[mm][bj] = *(const u32x4*)(PW + off); }
#pragma unroll
                for (int mm = 0; mm < 2; ++mm) { const int m = 2 * mp + mm, row = EPI_ROWS(ai, m);
                    const float rstd = __builtin_amdgcn_rsqf(rq[ai][m] * (1.0f / 1024.0f) + EPSN); float ss = 0.f;
#pragma unroll
                    for (int bj = 0; bj < 2; ++bj) {
                        const u32x4 bb = xb[mm][bj], tt = t[mm][bj];
                        const f32x4 a0 = acc[ai][bj][m][0] * rstd, a1 = acc[ai][bj][m][1] * rstd;
                        f32x4 v0, v1;
                        v0[0] = bflo(bb.x) + sigmoidf_(a0[0]) * bflo(tt.x); v0[1] = bfhi(bb.x) + sigmoidf_(a0[1]) * bfhi(tt.x); v0[2] = bflo(bb.y) + sigmoidf_(a0[2]) * bflo(tt.y); v0[3] = bfhi(bb.y) + sigmoidf_(a0[3]) * bfhi(tt.y);
                        v1[0] = bflo(bb.z) + sigmoidf_(a1[0]) * bflo(tt.z); v1[1] = bfhi(bb.z) + sigmoidf_(a1[1]) * bfhi(tt.z); v1[2] = bflo(bb.w) + sigmoidf_(a1[2]) * bflo(tt.w); v1[3] = bfhi(bb.w) + sigmoidf_(a1[3]) * bfhi(tt.w);
                        store8(X3B + (size_t)row * 1024 + EPI_COL(bj), v0, v1);
                        ss += (v0[0] * v0[0] + v0[1] * v0[1]) + (v0[2] * v0[2] + v0[3] * v0[3]) + (v1[0] * v1[0] + v1[1] * v1[1]) + (v1[2] * v1[2] + v1[3] * v1[3]); }
                    ss += __shfl_xor(ss, 16); ss += __shfl_xor(ss, 32);
                    ssv[m] = ss; }
                asm volatile("" ::: "memory");
            }
            rowsum_atomic4(rowsq3, ssv, EPI_ROWS(ai, 0), fq); }
    }
};

constexpr int A_K0 = 0, A_KB = 13312, A_V0 = 4 * A_KB, A_VB = 9216, A_TBL = A_V0 + 4 * A_VB + 1024;
static_assert(A_TBL + 465 * 4 < 131072, "attention LDS");

__device__ __forceinline__ float max3f(float a, float b, float c) { float r; asm("v_max3_f32 %0, %1, %2, %3" : "=v"(r) : "v"(a), "v"(b), "v"(c)); return r; }
__device__ __forceinline__ float rowmax32(const f32x16& p0, const f32x16& p1) {
    float a = max3f(p0[0], p0[1], p1[0]), b = max3f(p0[2], p0[3], p1[1]); a = max3f(a, p1[2], p1[3]);
#pragma unroll
    for (int r = 4; r < 16; r += 4) { a = max3f(a, p0[r], p0[r + 1]); b = max3f(b, p0[r + 2], p0[r + 3]); a = max3f(a, p1[r], p1[r + 1]); b = max3f(b, p1[r + 2], p1[r + 3]); }
    const float m = fmaxf(a, b);
    auto rr = __builtin_amdgcn_permlane32_swap(__float_as_uint(m), __float_as_uint(m), false, false);
    return fmaxf(__uint_as_float(rr[0]), __uint_as_float(rr[1]));
}
__device__ __forceinline__ void glds16(const void* gsrc, unsigned lds_dst) { unsigned keep;
    asm volatile("s_mov_b32 %0, m0\n\ts_mov_b32 m0, %2\n\ts_nop 0\n\tglobal_load_lds_dwordx4 %1, off\n\ts_mov_b32 m0, %0" : "=&s"(keep) : "v"(gsrc), "s"(lds_dst) : "memory"); }
template <int LO, int HI> __device__ __forceinline__ void g_exp(f32x16& X) {
#pragma unroll
    for (int r = LO; r < HI; ++r) X[r] = __builtin_amdgcn_exp2f(X[r]);
}
template <int LO, int HI> __device__ __forceinline__ void g_sumpk(const f32x16& X, float& psa, float& psb, u32x4& pwlo, u32x4& pwhi) {
#pragma unroll
    for (int r = LO; r < HI; r += 2) { psa += X[r]; psb += X[r + 1]; const unsigned w = pk2(X[r], X[r + 1]); if (r < 8) pwlo[(r >> 1) & 3] = w; else pwhi[(r >> 1) & 3] = w; }
    asm volatile("" : "+v"(psa), "+v"(psb));
}
constexpr float A_THR = 8.0f;

template <bool NA>
__device__ __forceinline__ void attn_unit(LAS unsigned char* lds, const bf16_t* Q, const bf16_t* Kg, const bf16_t* Kr, const bf16_t* Vt, bf16_t* O,
                                          int h, int seqrow0, int q0, int t0, int NT, int rows, int g0, const float* rpb_h, int wid) {
    constexpr int DQK = NA ? 64 : 96, NJ = DQK / 16, KP = DQK + 8, QPITCH = NA ? 512 : 768;
    const int lane = my_lane(), tid = wid * 64 + lane, r32 = lane & 31, hi = lane >> 5;
    const int kvr = tid >> 3, c8 = tid & 7;
    const bf16_t* ksrc = Kg + (size_t)(seqrow0 + t0 * 64 + kvr) * 512 + h * 64 + 8 * c8;
    const bf16_t* rsrc = NA ? nullptr : Kr + (size_t)(seqrow0 + t0 * 64 + (tid >> 2)) * 32 + 8 * (tid & 3);
    const bf16_t* vsrc = Vt + (size_t)(h * 64 + kvr) * MT + seqrow0 + t0 * 64 + 8 * c8;
    const unsigned kdst = A_K0 + (kvr * KP + 8 * c8) * 2, rdst = A_K0 + ((tid >> 2) * KP + 64 + 8 * (tid & 3)) * 2, vdst = A_V0 + (kvr * 72 + 16 * (c8 >> 1) + 4 * (c8 & 1)) * 2;
    u32x4 rk, rr, rv;
#define A_LOADK(t) do { const int tt_ = (t) < NT ? (t) : NT - 1; const size_t ro = (size_t)(tt_ * 64); rk = *(const u32x4*)(ksrc + ro * 512); if (!NA && tid < 256) rr = *(const u32x4*)(rsrc + ro * 32); } while (0)
#define A_LOADV(t) do { const int tt_ = (t) < NT ? (t) : NT - 1; rv = *(const u32x4*)(vsrc + (size_t)(tt_ * 64)); } while (0)
#define A_STOREK(b) do { *(LAS u32x4*)(lds + kdst + (b) * A_KB) = rk; if (!NA && tid < 256) *(LAS u32x4*)(lds + rdst + (b) * A_KB) = rr; } while (0)
#define A_STOREV(b) do { *(LAS u32x2*)(lds + vdst + (b) * A_VB) = (u32x2){rv.x, rv.y}; *(LAS u32x2*)(lds + vdst + (b) * A_VB + 16) = (u32x2){rv.z, rv.w}; } while (0)
    int g = 0, rs = 0, c = 0, cs = 0;
    if (NA) {
        g = g0 + (wid >> 1); rs = g - 4; rs = rs < 0 ? 0 : (rs > rows - 8 ? rows - 8 : rs);
        c = 32 * (wid & 1) + r32; cs = c - 8; cs = cs < 0 ? 0 : (cs > 48 ? 48 : cs);
        LAS float* tbl = (LAS float*)(lds + A_TBL);
        if (tid < 465) tbl[tid] = rpb_h[tid] * LOG2E;
    }
    const unsigned lds_u = (unsigned)(uintptr_t)lds;
    const char* dk_src[2] = {nullptr, nullptr}; unsigned dk_str[2] = {0u, 0u}; const char* dv_src[2] = {nullptr, nullptr};
    {
        constexpr int CPR = NA ? 9 : 13;
#pragma unroll
        for (int j = 0; j < 2; ++j) { const int ci = 64 * (wid + 8 * j) + lane, row = (ci / CPR) & 63, col = ci % CPR;
            const bool rope = !NA && (col >= 8 && col < 12);
            dk_src[j] = rope ? (const char*)(Kr + (size_t)(seqrow0 + t0 * 64 + row) * 32 + 8 * (col - 8)) : (const char*)(Kg + (size_t)(seqrow0 + t0 * 64 + row) * 512 + h * 64 + 8 * (col & 7));
            dk_str[j] = rope ? 64u * 64u : 64u * 1024u; }
#pragma unroll
        for (int j = 0; j < 2; ++j) { const int ci = 64 * (wid + 8 * j) + lane, row = ci / 9, col = ci - 9 * row;
            dv_src[j] = (const char*)(Vt + (size_t)(h * 64 + (row & 63)) * MT + seqrow0 + t0 * 64 + 8 * (col & 7)); }
    }
#define A_DMAK(t, slot) do { const unsigned tt_ = (unsigned)((t) < NT ? (t) : NT - 1); \
        glds16(dk_src[0] + (size_t)tt_ * dk_str[0], (unsigned)__builtin_amdgcn_readfirstlane(lds_u + A_K0 + (slot) * A_KB + wid * 1024)); \
        if (NA ? wid == 0 : wid < 5) glds16(dk_src[1] + (size_t)tt_ * dk_str[1], (unsigned)__builtin_amdgcn_readfirstlane(lds_u + A_K0 + (slot) * A_KB + (wid + 8) * 1024)); } while (0)
#define A_DMAV(t, slot) do { const unsigned tt_ = (unsigned)((t) < NT ? (t) : NT - 1); \
        glds16(dv_src[0] + (size_t)tt_ * 128u, (unsigned)__builtin_amdgcn_readfirstlane(lds_u + A_V0 + (slot) * A_VB + wid * 1024)); \
        if (wid == 0) glds16(dv_src[1] + (size_t)tt_ * 128u, (unsigned)__builtin_amdgcn_readfirstlane(lds_u + A_V0 + (slot) * A_VB + 8 * 1024)); } while (0)
    const size_t qrow = (size_t)(seqrow0 + q0 + wid * 32 + r32);
    bf16x8 qr[NJ];
#pragma unroll
    for (int j = 0; j < NJ; ++j) qr[j] = *(const bf16x8*)(Q + qrow * QPITCH + h * DQK + 16 * j + 8 * hi);
    f32x16 o0, o1, negm;
#pragma unroll
    for (int r = 0; r < 16; ++r) { o0[r] = 0.f; o1[r] = 0.f; negm[r] = 0.f; }
    float mref = 0.f, lrun = 0.f;
    const LAS unsigned char* kfb = lds + A_K0 + (r32 * KP + 8 * hi) * 2;
    const LAS unsigned char* vfb = lds + A_V0 + (r32 * 72 + 8 * hi) * 2;
#define A_QK(N0, N1, b) do { const LAS unsigned char* kp_ = kfb + (b) * A_KB; \
        _Pragma("unroll") for (int j = 0; j < NJ; ++j) { \
            const bf16x8 a0_ = *(const LAS bf16x8*)(kp_ + j * 32), a1_ = *(const LAS bf16x8*)(kp_ + 32 * KP * 2 + j * 32); \
            N0 = __builtin_amdgcn_mfma_f32_32x32x16_bf16(a0_, qr[j], j == 0 ? negm : N0, 0, 0, 0); \
            N1 = __builtin_amdgcn_mfma_f32_32x32x16_bf16(a1_, qr[j], j == 0 ? negm : N1, 0, 0, 0); } } while (0)
#define A_MASK(N0, N1, t) do { if (NA) { const int kr_ = t0 + (t); const bool act_ = (kr_ >= rs) && (kr_ < rs + 8) && ((t) < NT); \
        const LAS float* tb_ = (const LAS float*)(lds + A_TBL) + ((act_ ? kr_ - g + 7 : 0) * 31 + 15 - c + 4 * hi); const int kb_ = act_ ? 4 * hi - cs : -1000; \
        _Pragma("unroll") for (int r = 0; r < 16; ++r) { const int kc0 = (r & 3) + 8 * (r >> 2), kc1 = kc0 + 32; const float b0_ = tb_[kc0], b1_ = tb_[kc1]; \
            N0[r] = ((unsigned)(kb_ + kc0) < 16u) ? N0[r] + b0_ : -INFINITY; N1[r] = ((unsigned)(kb_ + kc1) < 16u) ? N1[r] + b1_ : -INFINITY; } } } while (0)
#define A_SB() __builtin_amdgcn_sched_barrier(0)
#define A_QKG(N0, N1, j) do { bf16x8 kn0_ = kf0_, kn1_ = kf1_; \
        if ((j) + 1 < NJ) { kn0_ = *(const LAS bf16x8*)(kp_ + ((j) + 1) * 32); kn1_ = *(const LAS bf16x8*)(kp_ + 32 * KP * 2 + ((j) + 1) * 32); } \
        else { kn0_ = *(const LAS bf16x8*)(vp_); kn1_ = *(const LAS bf16x8*)(vp_ + 32 * 144); } \
        N0 = __builtin_amdgcn_mfma_f32_32x32x16_bf16(kf0_, qr[j], (j) == 0 ? negm : N0, 0, 0, 0); \
        N1 = __builtin_amdgcn_mfma_f32_32x32x16_bf16(kf1_, qr[j], (j) == 0 ? negm : N1, 0, 0, 0); \
        kf0_ = kn0_; kf1_ = kn1_; } while (0)
#define A_PVG(blk) do { bf16x8 kn0_ = kf0_, kn1_ = kf1_; \
        if ((blk) + 1 < 4) { kn0_ = *(const LAS bf16x8*)(vp_ + ((blk) + 1) * 32); kn1_ = *(const LAS bf16x8*)(vp_ + 32 * 144 + ((blk) + 1) * 32); } \
        const bf16x8 pb_ = __builtin_bit_cast(bf16x8, pw_[blk]); \
        o0 = __builtin_amdgcn_mfma_f32_32x32x16_bf16(kf0_, pb_, o0, 0, 0, 0); \
        o1 = __builtin_amdgcn_mfma_f32_32x32x16_bf16(kf1_, pb_, o1, 0, 0, 0); \
        kf0_ = kn0_; kf1_ = kn1_; } while (0)
#define A_STEP(C0, C1, TMC, N0, N1, TMN, t) do { \
        const LAS unsigned char* kp_ = kfb + (((t) + 1) & 3) * A_KB; const LAS unsigned char* vp_ = vfb + ((t) & 3) * A_VB; \
        bf16x8 kf0_ = *(const LAS bf16x8*)(kp_), kf1_ = *(const LAS bf16x8*)(kp_ + 32 * KP * 2); \
        { const bool first_ = NA ? (t0 + (t) == rs) : ((t) == 0); \
          if (first_ || __any(TMC > A_THR)) { const float dl_ = first_ ? (TMC > -1e20f ? TMC : 0.f) : fmaxf(TMC, 0.f); mref += dl_; const float f_ = __builtin_amdgcn_exp2f(-dl_); lrun *= f_; \
              _Pragma("unroll") for (int r = 0; r < 16; ++r) { o0[r] *= f_; o1[r] *= f_; C0[r] -= dl_; C1[r] -= dl_; negm[r] = -mref; } } } \
        A_DMAK((t) + 3, ((t) + 3) & 3); A_DMAV((t) + 2, ((t) + 2) & 3); \
        u32x4 pw_[4]; float psa_ = 0.f, psb_ = 0.f; \
        A_SB(); \
        if constexpr (!NA) { \
            A_QKG(N0, N1, 0); g_exp<0, 6>(C0); A_SB(); \
            A_QKG(N0, N1, 1); g_exp<6, 12>(C0); g_sumpk<0, 6>(C0, psa_, psb_, pw_[0], pw_[1]); A_SB(); \
            A_QKG(N0, N1, 2); g_exp<12, 16>(C0); g_sumpk<6, 12>(C0, psa_, psb_, pw_[0], pw_[1]); A_SB(); \
            A_QKG(N0, N1, 3); g_exp<0, 6>(C1); g_sumpk<12, 16>(C0, psa_, psb_, pw_[0], pw_[1]); A_SB(); \
            A_QKG(N0, N1, 4); g_exp<6, 12>(C1); g_sumpk<0, 6>(C1, psa_, psb_, pw_[2], pw_[3]); A_SB(); \
            A_QKG(N0, N1, 5); g_exp<12, 16>(C1); g_sumpk<6, 12>(C1, psa_, psb_, pw_[2], pw_[3]); A_SB(); \
            A_PVG(0); g_sumpk<12, 16>(C1, psa_, psb_, pw_[2], pw_[3]); A_SB(); \
        } else { \
            A_QKG(N0, N1, 0); g_exp<0, 8>(C0); A_SB(); \
            A_QKG(N0, N1, 1); g_exp<8, 16>(C0); g_sumpk<0, 8>(C0, psa_, psb_, pw_[0], pw_[1]); A_SB(); \
            A_QKG(N0, N1, 2); g_exp<0, 8>(C1); g_sumpk<8, 16>(C0, psa_, psb_, pw_[0], pw_[1]); A_SB(); \
            A_QKG(N0, N1, 3); g_exp<8, 16>(C1); g_sumpk<0, 8>(C1, psa_, psb_, pw_[2], pw_[3]); A_SB(); \
            A_PVG(0); g_sumpk<8, 16>(C1, psa_, psb_, pw_[2], pw_[3]); A_SB(); \
        } \
        A_PVG(1); A_MASK(N0, N1, (t) + 1); A_SB(); \
        A_PVG(2); TMN = rowmax32(N0, N1); A_SB(); \
        A_PVG(3); lrun += psa_ + psb_; asm volatile("" :: "v"(negm));     \
        A_SB(); \
        if ((t) & 1) { asm volatile("s_waitcnt vmcnt(0)" ::: "memory"); __syncthreads(); } } while (0)

#define A_STEP_NA(C0, C1, TMC, N0, N1, TMN, t) do { \
        const int krc_ = t0 + (t); const bool actc_ = (krc_ >= rs) && (krc_ < rs + 8), actn_ = (krc_ + 1 >= rs) && (krc_ + 1 < rs + 8) && ((t) + 1 < NT); \
        A_DMAK((t) + 3, ((t) + 3) & 3); A_DMAV((t) + 2, ((t) + 2) & 3); \
        if (actc_) { const bool first_ = (krc_ == rs); \
          if (first_ || __any(TMC > A_THR)) { const float dl_ = first_ ? TMC : fmaxf(TMC, 0.f); mref += dl_; const float f_ = __builtin_amdgcn_exp2f(-dl_); lrun *= f_; \
              _Pragma("unroll") for (int r = 0; r < 16; ++r) { o0[r] *= f_; o1[r] *= f_; C0[r] -= dl_; C1[r] -= dl_; negm[r] = -mref; } } } \
        if (actn_) { A_QK(N0, N1, ((t) + 1) & 3); A_MASK(N0, N1, (t) + 1); TMN = rowmax32(N0, N1); } \
        if (actc_) { float ps_ = 0.f; \
            _Pragma("unroll") for (int r = 0; r < 16; ++r) { C0[r] = __builtin_amdgcn_exp2f(C0[r]); C1[r] = __builtin_amdgcn_exp2f(C1[r]); ps_ += C0[r] + C1[r]; } \
            lrun += ps_; \
            u32x4 pw_[4]; \
            pw_[0] = (u32x4){pk2(C0[0], C0[1]), pk2(C0[2], C0[3]), pk2(C0[4], C0[5]), pk2(C0[6], C0[7])}; \
            pw_[1] = (u32x4){pk2(C0[8], C0[9]), pk2(C0[10], C0[11]), pk2(C0[12], C0[13]), pk2(C0[14], C0[15])}; \
            pw_[2] = (u32x4){pk2(C1[0], C1[1]), pk2(C1[2], C1[3]), pk2(C1[4], C1[5]), pk2(C1[6], C1[7])}; \
            pw_[3] = (u32x4){pk2(C1[8], C1[9]), pk2(C1[10], C1[11]), pk2(C1[12], C1[13]), pk2(C1[14], C1[15])}; \
            const LAS unsigned char* vp_ = vfb + ((t) & 3) * A_VB; \
            _Pragma("unroll") for (int blk = 0; blk < 4; ++blk) { \
                const bf16x8 va0 = *(const LAS bf16x8*)(vp_ + blk * 32), va1 = *(const LAS bf16x8*)(vp_ + 32 * 144 + blk * 32); \
                const bf16x8 pb_ = __builtin_bit_cast(bf16x8, pw_[blk]); \
                o0 = __builtin_amdgcn_mfma_f32_32x32x16_bf16(va0, pb_, o0, 0, 0, 0); \
                o1 = __builtin_amdgcn_mfma_f32_32x32x16_bf16(va1, pb_, o1, 0, 0, 0); } } \
        if ((t) & 1) { asm volatile("s_waitcnt vmcnt(0)" ::: "memory"); __syncthreads(); } } while (0)

    { A_DMAK(0, 0); A_DMAV(0, 0); A_DMAK(1, 1); A_DMAK(2, 2); A_DMAV(1, 1); }
    asm volatile("s_waitcnt vmcnt(0)" ::: "memory");
    __syncthreads();
    f32x16 sA0, sA1, sB0, sB1; float tmA, tmB;
    A_QK(sA0, sA1, 0);
    A_MASK(sA0, sA1, 0);
    tmA = rowmax32(sA0, sA1);
    __syncthreads();
    if constexpr (NA) {
        for (int t = 0; t < NT; t += 2) {
            A_STEP_NA(sA0, sA1, tmA, sB0, sB1, tmB, t);
            if (t + 1 < NT) A_STEP_NA(sB0, sB1, tmB, sA0, sA1, tmA, t + 1);
        }
        if (NT & 1) { asm volatile("s_waitcnt vmcnt(0)" ::: "memory"); __syncthreads(); }
    } else {
        for (int t = 0; t < NT; t += 4) {
            A_STEP(sA0, sA1, tmA, sB0, sB1, tmB, t);
            A_STEP(sB0, sB1, tmB, sA0, sA1, tmA, t + 1);
            A_STEP(sA0, sA1, tmA, sB0, sB1, tmB, t + 2);
            A_STEP(sB0, sB1, tmB, sA0, sA1, tmA, t + 3);
        }
    }
    const float lt = lrun + __shfl_xor(lrun, 32);
    const float inv = 1.0f / lt;
    bf16_t* orow = O + qrow * 512 + h * 64 + 4 * hi;
#pragma unroll
    for (int gq = 0; gq < 4; ++gq) {
        u32x2 w0, w1;
        w0.x = pk2(o0[4 * gq] * inv, o0[4 * gq + 1] * inv); w0.y = pk2(o0[4 * gq + 2] * inv, o0[4 * gq + 3] * inv);
        w1.x = pk2(o1[4 * gq] * inv, o1[4 * gq + 1] * inv); w1.y = pk2(o1[4 * gq + 2] * inv, o1[4 * gq + 3] * inv);
        *(u32x2*)(orow + 8 * gq) = w0; *(u32x2*)(orow + 32 + 8 * gq) = w1;
    }
#undef A_LOADK
#undef A_LOADV
#undef A_STOREK
#undef A_STOREV
#undef A_QK
#undef A_MASK
#undef A_STEP
#undef A_DMAK
#undef A_DMAV
#undef A_STEP_NA
#undef A_SB
#undef A_QKG
#undef A_PVG
}

template <class Map>
__device__ __forceinline__ void transpose_item(const float* W, int ldw, int K, int N, bf16_t* WT, const float* gain, LAS float* scr, int item, int lane, Map map) {
    const int nblk = N / 32, kb = item / nblk, nb = item % nblk, k0 = 64 * kb, n0 = 32 * nb;
    const int src = map(n0 + (lane & 31));
#pragma unroll 8
    for (int i = 0; i < 32; ++i) { const int kk = 2 * i + (lane >> 5); float v = 0.f; if (src >= 0) { v = W[(size_t)(k0 + kk) * ldw + src]; if (gain) v *= gain[k0 + kk]; } scr[kk * 33 + (lane & 31)] = v; }
    asm volatile("s_waitcnt lgkmcnt(0)" ::: "memory");
    const int c = lane & 7;
#pragma unroll
    for (int j = 0; j < 4; ++j) { const int n = (lane >> 3) + 8 * j; const LAS float* s = scr + (8 * c) * 33 + n;
        u32x4 o; o.x = pk2(s[0 * 33], s[1 * 33]); o.y = pk2(s[2 * 33], s[3 * 33]); o.z = pk2(s[4 * 33], s[5 * 33]); o.w = pk2(s[6 * 33], s[7 * 33]);
        *(u32x4*)(WT + (size_t)(n0 + n) * K + k0 + 8 * c) = o; }
    asm volatile("s_waitcnt lgkmcnt(0)" ::: "memory");
}
__device__ __forceinline__ float2 rope_cs(int pos, int i) {
    const int a = i & 3, b = i >> 2;
    const double cf = a == 0 ? 1.0 : a == 1 ? 0.5623413251903491 : a == 2 ? 0.31622776601683794 : 0.1778279410038923;
    const double sf = b == 0 ? 1.0 : b == 1 ? 0.1 : b == 2 ? 0.01 : 0.001;
    double rev = (double)pos * (cf * sf) * 0.15915494309189535;
    rev -= __builtin_floor(rev);
    const float fr = (float)rev;
    return make_float2(__builtin_amdgcn_cosf(fr), __builtin_amdgcn_sinf(fr));
}
__device__ __forceinline__ int rope_perm(int p) { return 16 * ((p >> 2) & 1) + 4 * (p >> 3) + (p & 3); }

#define XB_TMO      128
#define XB_XCNT(j)  (256  + 64 * (j))
#define XB_XSUB(j)  (1280 + 64 * (j))
#define XB_XGEN(j)  (2304 + 64 * (j))
#define XB_TOP      3328
#define XB_TOPGEN   3392
#define XCD_BAR_WORDS 3456
#define XB_SPIN_CAP (1u << 18)

__device__ __forceinline__ unsigned xb_ld(unsigned* p)              { return __hip_atomic_load(p, __ATOMIC_RELAXED, __HIP_MEMORY_SCOPE_AGENT); }
__device__ __forceinline__ unsigned xb_add(unsigned* p, unsigned v) { return __hip_atomic_fetch_add(p, v, __ATOMIC_RELAXED, __HIP_MEMORY_SCOPE_AGENT); }
__device__ __forceinline__ unsigned xb_xcc_id() { return (unsigned)__builtin_amdgcn_s_getreg((3 << 11) | 20) & 0xFu; }
#define XB_SPIN(cond, bar) do { unsigned _sp = 0; while (cond) { __builtin_amdgcn_s_sleep(1); \
    if ((++_sp & 255u) == 0u) { if (xb_ld(&(bar)[XB_TMO])) break; if (_sp > XB_SPIN_CAP) { atomicAdd(&(bar)[XB_TMO], 1u); break; } } } } while (0)

struct XcdBarrier {
    unsigned* bar; unsigned x;
    volatile LAS unsigned* st;
};

__device__ __forceinline__ XcdBarrier xcd_barrier_post(unsigned* bar, volatile LAS unsigned* st) {
    XcdBarrier b; b.bar = bar; b.x = xb_xcc_id(); b.st = st;
    if (threadIdx.x == 0) (void)xb_add(&bar[XB_XCNT(b.x)], 1u);
    return b;
}
__device__ __forceinline__ void xcd_barrier_complete(unsigned* bar, unsigned x, unsigned& nloc, unsigned& nx) {
    const unsigned G = gridDim.x * gridDim.y * gridDim.z;
    unsigned sum, cnt, mine, sp = 0u;
    for (;;) {
        sum = 0u; cnt = 0u; mine = 0u;
#pragma unroll
        for (unsigned j = 0; j < 16; ++j) { const unsigned c = xb_ld(&bar[XB_XCNT(j)]); sum += c; cnt += (c > 0u) ? 1u : 0u; mine = (j == x) ? c : mine; }
        if (sum == G) break;
        __builtin_amdgcn_s_sleep(1);
        if ((++sp & 255u) == 0u) { if (xb_ld(&bar[XB_TMO])) break; if (sp > XB_SPIN_CAP) { atomicAdd(&bar[XB_TMO], 1u); break; } }
    }
    nloc = mine > 0u ? mine : 1u; nx = cnt > 0u ? cnt : 1u;
}

__device__ __forceinline__ void xcd_barrier(const XcdBarrier& b) {
    asm volatile("s_waitcnt vmcnt(0)" ::: "memory");
    __syncthreads();
    if (threadIdx.x == 0) {
        unsigned* bar = b.bar;
        __builtin_amdgcn_s_waitcnt(0);
        unsigned nloc = b.st[0], nx = b.st[1];
        if (nloc == 0u) { xcd_barrier_complete(bar, b.x, nloc, nx); b.st[0] = nloc; b.st[1] = nx; }
        const unsigned old = xb_add(&bar[XB_XSUB(b.x)], 1u);
        const unsigned gen = old / nloc;
        if (old + 1u == (gen + 1u) * nloc) {
            __builtin_amdgcn_fence(__ATOMIC_RELEASE, "agent");
            asm volatile("s_waitcnt vmcnt(0)" ::: "memory");
            const unsigned og = xb_add(&bar[XB_TOP], 1u);
            const unsigned tg = og / nx;
            if (og + 1u == (tg + 1u) * nx) xb_add(&bar[XB_TOPGEN], 1u);
            else XB_SPIN(xb_ld(&bar[XB_TOPGEN]) == tg, bar);
            __builtin_amdgcn_fence(__ATOMIC_ACQUIRE, "agent");
            xb_add(&bar[XB_XGEN(b.x)], 1u);
            asm volatile("s_waitcnt vmcnt(0)" ::: "memory");
        } else {
            XB_SPIN(xb_ld(&bar[XB_XGEN(b.x)]) == gen, bar);
            __builtin_amdgcn_fence(__ATOMIC_ACQUIRE, "agent");
            asm volatile("s_waitcnt vmcnt(0)" ::: "memory");
        }
    }
    __syncthreads();
}

#define Wt_in ((bf16_t*)(kp->ws + W_IN))
#define Wt_vna ((bf16_t*)(kp->ws + W_VNA))
#define Wt_uq ((bf16_t*)(kp->ws + W_UQ))
#define Wt_uk ((bf16_t*)(kp->ws + W_UK))
#define Wt_uv ((bf16_t*)(kp->ws + W_UV))
#define Wt_nao ((bf16_t*)(kp->ws + W_NAO))
#define Wt_mlao ((bf16_t*)(kp->ws + W_MLAO))
#define Wt_out ((bf16_t*)(kp->ws + W_OUT))
#define Wt_gu ((bf16_t*)(kp->ws + W_GU))
#define Wt_dn ((bf16_t*)(kp->ws + W_DN))
#define Wt_pg ((bf16_t*)(kp->ws + W_PG))
#define Wt_pl ((bf16_t*)(kp->ws + W_PL))
#define ropetab ((float2*)(kp->ws + WS_ROPE))
#define rsq1 ((float*)(kp->ws + WS_RSQ))
#define krope ((bf16_t*)(kp->ws + WS_KROPE))
#define PB ((bf16_t*)(kp->ws + WS_PB))
#define XN ((bf16_t*)(kp->ws + WS_XN))
#define QNA ((bf16_t*)(kp->ws + WS_QNA))
#define KNA ((bf16_t*)(kp->ws + WS_KNA))
#define VTNA ((bf16_t*)(kp->ws + WS_VTNA))
#define ZLAT ((bf16_t*)(kp->ws + WS_ZLAT))
#define ZQN ((bf16_t*)(kp->ws + WS_ZQN))
#define ZKVN ((bf16_t*)(kp->ws + WS_ZKVN))
#define QM ((bf16_t*)(kp->ws + WS_QM))
#define KN ((bf16_t*)(kp->ws + WS_KN))
#define VTM ((bf16_t*)(kp->ws + WS_VTM))
#define MLAO ((bf16_t*)(kp->ws + WS_MLAO))
#define T1 ((bf16_t*)(kp->ws + WS_T1))
#define U ((bf16_t*)(kp->ws + WS_U))
#define XB1 ((bf16_t*)(kp->ws + WS_XB1))
#define HB ((bf16_t*)(kp->ws + WS_H))
#define XB2 ((bf16_t*)(kp->ws + WS_XB2))
#define PW ((bf16_t*)(kp->ws + WS_PW))
#define X3B ((bf16_t*)(kp->ws + 476 * MiB))
#define rsqQ (rsq1 + 3 * MT)
#define rsqKV (rsq1 + 4 * MT)
#define rsq2 (rsq1 + MT)
#define rsq3 (rsq1 + 2 * MT)
#define NAO QNA
#define GATES ((bf16_t*)kp->out)

typedef const __attribute__((address_space(4))) Params KParams;
__device__ __forceinline__ KParams* kparams() { unsigned long long p = (unsigned long long)__builtin_amdgcn_kernarg_segment_ptr(); asm volatile("" : "+s"(p)); return (KParams*)p; }
#define KP_RELOAD kp = kparams()
__global__ void __launch_bounds__(512, 2) fwd_kernel(Params P) {
    extern __shared__ __attribute__((aligned(16))) unsigned char lds_raw[];
    LAS unsigned char* lds = (LAS unsigned char*)lds_raw;
    cg::grid_group grid = cg::this_grid();
    const KParams* kp;
    KP_RELOAD;
    { volatile LAS unsigned* st0 = (volatile LAS unsigned*)(lds + LDS_BYTES - 64); if (threadIdx.x < 16) st0[threadIdx.x] = 0u; __syncthreads(); }
    const XcdBarrier xbar = xcd_barrier_post((unsigned*)(kp->ws + WS_CTL), (volatile LAS unsigned*)(lds + LDS_BYTES - 64));

    const int wave = __builtin_amdgcn_readfirstlane(threadIdx.x >> 6);
    const int G = gridDim.x, bx = blockIdx.x;
    const int vcu = (G % 8 == 0) ? (bx % 8) * (G / 8) + bx / 8 : bx;
    const int gw = vcu * 8 + wave, NGW = G * 8;
    KP_RELOAD;
    if constexpr (PHASES & 1) {
        const int lane = my_lane();
        LAS float* scr = (LAS float*)(lds + wave * 16384);
        constexpr int I_IN = 16 * (NIN / 32), I_VNA = 16 * 16, I_UQ = 6 * 24, I_UK = 4 * 16, I_UV = 4 * 16, I_NAO = 8 * 32, I_MLAO = 8 * 32, I_OUT = 16 * 32, I_GU = 16 * 176, I_DN = 44 * 32, I_PG = 16 * 32, I_PL = 4 * 32;
        constexpr int NITEMS = I_IN + I_VNA + I_UQ + I_UK + I_UV + I_NAO + I_MLAO + I_OUT + I_GU + I_DN + I_PG + I_PL;
        for (int it = gw; it < NITEMS; it += NGW) {
            int r = it;
            if (r < I_IN) { transpose_item(kp->w_in, 4256, 1024, NIN, Wt_in, nullptr, scr, r, lane, [](int n) { if (n < 1024) return n; if (n < 3072) return 2208 + (n - 1024); const int t = n - 3072; return t < 672 ? 1536 + t : -1; }); continue; } r -= I_IN;
            if (r < I_VNA) { transpose_item(kp->w_in, 4256, 1024, 512, Wt_vna, nullptr, scr, r, lane, [](int n) { return 1024 + n; }); continue; } r -= I_VNA;
            if (r < I_UQ) { transpose_item(kp->w_uq, 768, 384, 768, Wt_uq, kp->g_q, scr, r, lane, [](int n) { const int hh = n / 96, rr = n % 96; return rr < 64 ? n : hh * 96 + 64 + rope_perm(rr - 64); }); continue; } r -= I_UQ;
            if (r < I_UK) { transpose_item(kp->w_ukv, 1024, 256, 512, Wt_uk, kp->g_kv, scr, r, lane, [](int n) { return (n >> 6) * 128 + (n & 63); }); continue; } r -= I_UK;
            if (r < I_UV) { transpose_item(kp->w_ukv, 1024, 256, 512, Wt_uv, kp->g_kv, scr, r, lane, [](int n) { return (n >> 6) * 128 + 64 + (n & 63); }); continue; } r -= I_UV;
            if (r < I_NAO) { transpose_item(kp->w_nao, 1024, 512, 1024, Wt_nao, nullptr, scr, r, lane, [](int n) { return n; }); continue; } r -= I_NAO;
            if (r < I_MLAO) { transpose_item(kp->w_mlao, 1024, 512, 1024, Wt_mlao, nullptr, scr, r, lane, [](int n) { return n; }); continue; } r -= I_MLAO;
            if (r < I_OUT) { transpose_item(kp->w_out, 1024, 1024, 1024, Wt_out, nullptr, scr, r, lane, [](int n) { return n; }); continue; } r -= I_OUT;
            if (r < I_GU) { transpose_item(kp->w_gu, 5632, 1024, 5632, Wt_gu, kp->g_ffn, scr, r, lane, [](int n) { const int j = (n >> 3) * 4 + (n & 3); return ((n >> 2) & 1) ? DFF + j : j; }); continue; } r -= I_GU;
            if (r < I_DN) { transpose_item(kp->w_dn, 1024, 2816, 1024, Wt_dn, nullptr, scr, r, lane, [](int n) { return n; }); continue; } r -= I_DN;
            if (r < I_PG) { transpose_item(kp->w_pg, 1024, 1024, 1024, Wt_pg, kp->g_ple, scr, r, lane, [](int n) { return n; }); continue; } r -= I_PG;
            transpose_item(kp->w_pl, 1024, 256, 1024, Wt_pl, nullptr, scr, r, lane, [](int n) { return n; });
        }
        {
            f32x4 gmix[4];
#pragma unroll
            for (int j = 0; j < 4; ++j) gmix[j] = *(const f32x4*)(kp->g_mix + 4 * lane + 256 * j);
            for (int m0 = gw; m0 < MT; m0 += 4 * NGW) {
                f32x4 v[4][4], pv[4];
#pragma unroll
                for (int u = 0; u < 4; ++u) { const int m = m0 + u * NGW < MT ? m0 + u * NGW : m0;
                    const float* xr = m < MP ? kp->x_p + (size_t)m * 1024 : kp->x_s + (size_t)(m - MP) * 1024;
                    const float* pr = m < MP ? kp->p_p + (size_t)m * 256 : kp->p_s + (size_t)(m - MP) * 256;
#pragma unroll
                    for (int j = 0; j < 4; ++j) v[u][j] = *(const f32x4*)(xr + 4 * lane + 256 * j);
                    pv[u] = *(const f32x4*)(pr + 4 * lane); }
#pragma unroll
                for (int u = 0; u < 4; ++u) { const int m = m0 + u * NGW < MT ? m0 + u * NGW : m0; float s = 0.f;
#pragma unroll
                    for (int j = 0; j < 4; ++j) s += (v[u][j][0] * v[u][j][0] + v[u][j][1] * v[u][j][1]) + (v[u][j][2] * v[u][j][2] + v[u][j][3] * v[u][j][3]);
                    const float rstd = __builtin_amdgcn_rsqf(wave_sum(s) * (1.0f / 1024.0f) + EPSN);
#pragma unroll
                    for (int j = 0; j < 4; ++j) { const f32x4 gg = gmix[j]; u32x2 w; w.x = pk2(v[u][j][0] * rstd * gg[0], v[u][j][1] * rstd * gg[1]); w.y = pk2(v[u][j][2] * rstd * gg[2], v[u][j][3] * rstd * gg[3]);
                        *(u32x2*)(XN + (size_t)m * 1024 + 4 * lane + 256 * j) = w; }
                    u32x2 w; w.x = pk2(pv[u][0], pv[u][1]); w.y = pk2(pv[u][2], pv[u][3]);
                    *(u32x2*)(PB + (size_t)m * 256 + 4 * lane) = w; }
            }
        }
        for (int i = gw * 64 + lane; i < SS * 16; i += NGW * 64) ropetab[i] = rope_cs(i >> 4, i & 15);
        for (int i = gw * 64 + lane; i < 5 * MT; i += NGW * 64) rsq1[i] = 0.f;
    }
    if (kp->ws == nullptr) grid.sync();
    xcd_barrier(xbar);

    KP_RELOAD;
    if constexpr (PHASES & 2) {
        pg8::Gemm g{XN, Wt_in, MT, NIN, opq(1024)}; pg8::StaticOrder S; S.init(MT, NIN, G, bx);
        EpiIn E{QNA, KNA, GATES, ZLAT, rsqQ, rsqKV};
        pg8::gemm_phase<EpiIn, pg8::StaticOrder, true, true>(lds, g, S, E, wave * 64 + my_lane());
        pg8::Gemm g2{Wt_vna, XN, 512, MT, opq(1024)}; pg8::StaticOrder S2; S2.init(512, MT, G, bx);
        EpiPlainPermT E2{VTNA, MT};
        pg8::gemm_phase<EpiPlainPermT, pg8::StaticOrder, true, true>(lds, g2, S2, E2, wave * 64 + my_lane());
    }
    xcd_barrier(xbar);

    KP_RELOAD;
    if constexpr (PHASES & 8) {
        for (int i0 = gw * 64 + my_lane(); i0 < MT * 16; i0 += 4 * NGW * 64) {
            float x1[4], x2[4]; float2 cs[4];
#pragma unroll
            for (int u = 0; u < 4; ++u) { const int i = i0 + u * NGW * 64 < MT * 16 ? i0 + u * NGW * 64 : i0; const int m = i >> 4, ii = i & 15;
                const bf16_t* zr = ZLAT + (size_t)m * 768 + 640; x1[u] = bf2f(zr[ii]); x2[u] = bf2f(zr[16 + ii]); cs[u] = ropetab[(size_t)row_pos(m) * 16 + ii]; }
#pragma unroll
            for (int u = 0; u < 4; ++u) { const int i = i0 + u * NGW * 64 < MT * 16 ? i0 + u * NGW * 64 : i0; const int m = i >> 4, ii = i & 15;
                bf16_t* ko = krope + (size_t)m * 32 + 8 * (ii >> 2) + (ii & 3);
                ko[0] = (bf16_t)(pk2(x1[u] * cs[u].x - x2[u] * cs[u].y, 0.f) & 0xffffu); ko[4] = (bf16_t)(pk2(x2[u] * cs[u].x + x1[u] * cs[u].y, 0.f) & 0xffffu); }
        }
        pg8::Gemm g{ZLAT, Wt_uq, MT, 768, opq(384), 768, 0}; pg8::StaticOrder S; S.init(MT, 768, G, bx);
        EpiQRope E{QM, ropetab, rsqQ};
        pg8::gemm_phase<EpiQRope, pg8::StaticOrder, true, true>(lds, g, S, E, wave * 64 + my_lane());
        pg8::Gemm g2{ZLAT + 384, Wt_uk, MT, 512, opq(256), 768, 0}; pg8::StaticOrder S2; S2.init(MT, 512, G, bx);
        EpiRowScale E2{KN, 512, rsqKV, 1.0f / 256.0f};
        pg8::gemm_phase<EpiRowScale, pg8::StaticOrder, true, true>(lds, g2, S2, E2, wave * 64 + my_lane());
        pg8::Gemm g3{Wt_uv, ZLAT + 384, 512, MT, opq(256), 0, 768}; pg8::StaticOrder S3; S3.init(512, MT, G, bx);
        EpiColScale E3{VTM, MT, rsqKV, 1.0f / 256.0f};
        pg8::gemm_phase<EpiColScale, pg8::StaticOrder, true, true>(lds, g3, S3, E3, wave * 64 + my_lane());
    }
    xcd_barrier(xbar);

    KP_RELOAD;
    if constexpr (PHASES & 16) {
        for (int u = vcu; u < 3072; u += G) {
            int seqrow0, h, rg, rows;
            if (u < 2048) { seqrow0 = (u >> 8) * SP; h = (u >> 5) & 7; rg = u & 31; rows = 128; }
            else { const int v = u - 2048; seqrow0 = MP + (v >> 9) * SS; h = (v >> 6) & 7; rg = v & 63; rows = 256; }
            const int g0 = 4 * rg;
            int lo = g0 - 4; lo = lo < 0 ? 0 : (lo > rows - 8 ? rows - 8 : lo);
            int hi_ = g0 - 1; hi_ = hi_ < 0 ? 0 : (hi_ > rows - 8 ? rows - 8 : hi_); hi_ += 7;
            attn_unit<true>(lds, QNA, KNA, nullptr, VTNA, NAO, h, seqrow0, 256 * rg, lo, hi_ - lo + 1, rows, g0, kp->rpb + h * 465, wave);
        }
        for (int u = vcu; u < 2048; u += G) {
            const int pair = u >> 5, qb = u & 31;
            attn_unit<false>(lds, QM, KN, krope, VTM, MLAO, pair & 7, (pair >> 3) * SP, 256 * qb, 0, SP / 64, 0, 0, nullptr, wave);
        }
        for (int u = vcu; u < 1024; u += G) {
            const int pair = u >> 6, qb = u & 63;
            attn_unit<false>(lds, QM, KN, krope, VTM, MLAO, pair & 7, MP + (pair >> 3) * SS, 256 * qb, 0, SS / 64, 0, 0, nullptr, wave);
        }
    }
    xcd_barrier(xbar);

    KP_RELOAD;
    if constexpr (PHASES & 32) {
        pg8::Gemm g{NAO, Wt_nao, MT, 1024, opq(512), 0, 0, MLAO, Wt_mlao}; pg8::DualOrder S; S.b.init(MT, 1024, G, bx);
        EpiGateDual E{U, GATES};
        pg8::gemm_phase<EpiGateDual, pg8::DualOrder, true, true>(lds, g, S, E, wave * 64 + my_lane());
    }
    xcd_barrier(xbar);

    KP_RELOAD;
    if constexpr (PHASES & 64) {
        pg8::Gemm g{U, Wt_out, MT, 1024, opq(1024)}; pg8::StaticOrder S; S.init(MT, 1024, G, bx);
        EpiResid<false> E{kp->x_p, kp->x_s, nullptr, XB1, rsq1};
        pg8::gemm_phase<EpiResid<false>, pg8::StaticOrder, true, true>(lds, g, S, E, wave * 64 + my_lane());
    }
    xcd_barrier(xbar);

    KP_RELOAD;
    if constexpr (PHASES & 128) {
        pg8::Gemm g{XB1, Wt_gu, MT, 5632, opq(1024)}; pg8::StaticOrder S; S.init(MT, 5632, G, bx);
        EpiGLU E{HB, rsq1};
        pg8::gemm_phase<EpiGLU, pg8::StaticOrder, true, true>(lds, g, S, E, wave * 64 + my_lane());
    }
    xcd_barrier(xbar);

    KP_RELOAD;
    if constexpr (PHASES & 256) {
        pg8::Gemm g{HB, Wt_dn, MT, 1024, opq(DFF)}; pg8::StaticOrder S; S.init(MT, 1024, G, bx);
        EpiResid<true> E{nullptr, nullptr, XB1, XB2, rsq2};
        pg8::gemm_phase<EpiResid<true>, pg8::StaticOrder, true, true>(lds, g, S, E, wave * 64 + my_lane());
    }
    xcd_barrier(xbar);

    KP_RELOAD;
    if constexpr (PHASES & 512) {
        pg8::Gemm g{PB, Wt_pl, MT, 1024, opq(256)}; pg8::StaticOrder S; S.init(MT, 1024, G, bx);
        EpiPlain E{PW, 1024};
        pg8::gemm_phase<EpiPlain, pg8::StaticOrder, true, true>(lds, g, S, E, wave * 64 + my_lane());
        pg8::Gemm g2{XB2, Wt_pg, MT, 1024, opq(1024)};
        EpiPle E2{XB2, X3B, PW, rsq2, rsq3};
        pg8::gemm_phase<EpiPle, pg8::StaticOrder, true, true>(lds, g2, S, E2, wave * 64 + my_lane());
    }
    xcd_barrier(xbar);

    KP_RELOAD;
    if constexpr (PHASES & 1024) {
        const int lane = my_lane();
        f32x4 gfin[4];
#pragma unroll
        for (int j = 0; j < 4; ++j) gfin[j] = *(const f32x4*)(kp->g_fin + 4 * lane + 256 * j);
        for (int m0 = gw; m0 < MT; m0 += 4 * NGW) {
            u32x2 v[4][4]; float rq[4];
#pragma unroll
            for (int u = 0; u < 4; ++u) { const int m = m0 + u * NGW < MT ? m0 + u * NGW : m0; rq[u] = rsq3[m];
#pragma unroll
                for (int j = 0; j < 4; ++j) v[u][j] = *(const u32x2*)(X3B + (size_t)m * 1024 + 4 * lane + 256 * j); }
#pragma unroll
            for (int u = 0; u < 4; ++u) { const int m = m0 + u * NGW < MT ? m0 + u * NGW : m0; if (u > 0 && m == m0) continue; const float rstd = __builtin_amdgcn_rsqf(rq[u] * (1.0f / 1024.0f) + EPSN);
#pragma unroll
                for (int j = 0; j < 4; ++j) { const f32x4 x = (f32x4){bflo(v[u][j].x), bfhi(v[u][j].x), bflo(v[u][j].y), bfhi(v[u][j].y)};
                    *(f32x4*)(kp->out + (size_t)m * 1024 + 4 * lane + 256 * j) = x * rstd * gfin[j]; } }
        }
    }
}

#undef Wt_in
#undef Wt_vna
#undef Wt_uq
#undef Wt_uk
#undef Wt_uv
#undef Wt_nao
#undef Wt_mlao
#undef Wt_out
#undef Wt_gu
#undef Wt_dn
#undef Wt_pg
#undef Wt_pl
#undef ropetab
#undef rsq1
#undef krope
#undef PB
#undef XN
#undef QNA
#undef KNA
#undef VTNA
#undef ZLAT
#undef ZQN
#undef ZKVN
#undef QM
#undef KN
#undef VTM
#undef MLAO
#undef T1
#undef U
#undef XB1
#undef HB
#undef XB2
#undef PW
#undef X3B
#undef rsqQ
#undef rsqKV
#undef rsq2
#undef rsq3
#undef NAO
#undef GATES

extern "C" void kernel_launch(void* const* d_in, const int* in_sizes, int n_in, void* d_out, int out_size, void* d_ws, size_t ws_size, hipStream_t stream) {
    static int grid_blocks = 0;
    if (grid_blocks == 0) {
        if (n_in != 21 || out_size != MT * DM || ws_size < WS_NEED) { fprintf(stderr, "kernel_launch: unexpected shapes (n_in %d out %d ws %zu)\n", n_in, out_size, ws_size); grid_blocks = -1; return; }
        int dev = 0, cus = 0, per_cu = 0;
        hipGetDevice(&dev);
        hipDeviceGetAttribute(&cus, hipDeviceAttributeMultiprocessorCount, dev);
        hipFuncSetAttribute((const void*)fwd_kernel, hipFuncAttributeMaxDynamicSharedMemorySize, LDS_BYTES);
        hipOccupancyMaxActiveBlocksPerMultiprocessor(&per_cu, (const void*)fwd_kernel, 512, LDS_BYTES);
        if (per_cu < 1) per_cu = 1;
        grid_blocks = cus * 1;
        (void)hipGetLastError();
    }
    if (grid_blocks < 0) return;
    if (hipMemsetAsync((unsigned char*)d_ws + WS_CTL, 0, CTL_BYTES, stream) != hipSuccess) { fprintf(stderr, "kernel_launch: memset failed\n"); return; }
    Params P{};
    const float** pp = (const float**)&P;
    for (int i = 0; i < 21; ++i) pp[i] = (const float*)d_in[i];
    P.out = (float*)d_out; P.ws = (unsigned char*)d_ws;
    void* args[] = {&P};
    hipError_t e = hipLaunchCooperativeKernel((const void*)fwd_kernel, dim3(grid_blocks), dim3(512), args, LDS_BYTES, stream);
    if (e != hipSuccess) fprintf(stderr, "cooperative launch failed: %s (grid %d)\n", hipGetErrorString(e), grid_blocks);
}
```
